# Optimizing an MI355X kernel written in HIP

```python
import math
import jax, jax.numpy as jnp
from jax import lax
import numpy as np

D_MODEL = 1024
BATCH = 8
SEQ = 8192
DEPTH = 1
DEC_BATCH = 32
DEC_SEQ = 32
PAST_LEN = 1024

CHUNK = 64
Q_BLOCK = 128
MIX_WIDTH = D_MODEL
CONV_CH = MIX_WIDTH // 2
CONV_GROUPS = 8
CONV_K = 3
N_ATT_HEADS = 4
DV = (MIX_WIDTH - CONV_CH) // N_ATT_HEADS
DQK = DV // 2
D_FF = 4 * D_MODEL
EPS = 1e-5
NEG_INF = -1e30
ATT_QK = N_ATT_HEADS * 2 * DQK
ATT_V = N_ATT_HEADS * DV
IN_WIDTH = 3 * CONV_CH + 2 * ATT_QK + ATT_V
SPLITS = [CONV_CH, 2 * CONV_CH, 3 * CONV_CH, 3 * CONV_CH + ATT_QK, 3 * CONV_CH + 2 * ATT_QK]

kernel_name = "hybrid_shortconv_diffattn_stream_step"


def rmsnorm(x, g):
    xf = x.astype(jnp.float32)
    y = xf * lax.rsqrt(jnp.mean(xf * xf, axis=-1, keepdims=True) + EPS) * g.astype(jnp.float32)
    return y.astype(x.dtype)


def alibi_slopes(n_heads):
    return jnp.asarray([2.0 ** (-8.0 * (i + 1) / n_heads) for i in range(n_heads)], dtype=jnp.float32)


def lambda_init_fn(layer_idx):
    return 0.8 - 0.6 * math.exp(-0.3 * layer_idx)


def diff_attention(q, k, v, q_pos, k_pos, lam):
    b, tq = q.shape[0], q.shape[1]
    slopes = alibi_slopes(N_ATT_HEADS)
    scale = DQK ** -0.5
    vf = v.astype(jnp.float32)

    def attend(args):
        qb, pb = args
        dist = jnp.abs(pb[:, None] - k_pos[None, :]).astype(jnp.float32)
        allowed = (k_pos[None, :] // CHUNK) <= (pb[:, None] // CHUNK)
        bias = -slopes[:, None, None] * dist[None]
        s = jnp.einsum('bqhcd,bkhcd->bhcqk', qb, k).astype(jnp.float32) * scale + bias[None, :, None]
        s = jnp.where(allowed[None, None, None], s, NEG_INF)
        p = jax.nn.softmax(s, axis=-1)
        w = p[:, :, 0] - lam * p[:, :, 1]
        return jnp.einsum('bhqk,bkhe->bqhe', w, vf).astype(q.dtype)

    if tq > Q_BLOCK and tq % Q_BLOCK == 0:
        nb = tq // Q_BLOCK
        qb = jnp.swapaxes(q.reshape(b, nb, Q_BLOCK, N_ATT_HEADS, 2, DQK), 0, 1)
        pb = q_pos.reshape(nb, Q_BLOCK)
        o = lax.map(attend, (qb, pb))
        return jnp.swapaxes(o, 0, 1).reshape(b, tq, N_ATT_HEADS, DV)
    return attend((q, q_pos))


def token_mix(h, w_in, conv_w, lq1, lk1, lq2, lk2, subln_g, w_o, conv_past, k_past, v_past,
              q_pos, k_pos, lam_init):
    b, t, _ = h.shape
    z = h @ w_in
    bg, cg, u, q, k, v = jnp.split(z, SPLITS, axis=-1)
    uc = cg * u
    padded = jnp.concatenate([conv_past.astype(uc.dtype), uc], axis=1)
    conv = conv_w[0] * padded[:, 0:t] + conv_w[1] * padded[:, 1:t + 1] + conv_w[2] * padded[:, 2:t + 2]
    y_conv = bg * conv
    new_conv = padded[:, -(CONV_K - 1):]
    k_new = k.reshape(b, t, N_ATT_HEADS, 2 * DQK)
    v_new = v.reshape(b, t, N_ATT_HEADS, DV)
    if k_past is None:
        k_all, v_all = k_new, v_new
    else:
        k_all = jnp.concatenate([k_past.astype(k_new.dtype), k_new], axis=1)
        v_all = jnp.concatenate([v_past.astype(v_new.dtype), v_new], axis=1)
    lam = (jnp.exp(jnp.sum(lq1.astype(jnp.float32) * lk1.astype(jnp.float32)))
           - jnp.exp(jnp.sum(lq2.astype(jnp.float32) * lk2.astype(jnp.float32))) + lam_init)
    o = diff_attention(q.reshape(b, t, N_ATT_HEADS, 2, DQK),
                       k_all.reshape(b, -1, N_ATT_HEADS, 2, DQK), v_all, q_pos, k_pos, lam)
    o = rmsnorm(o, subln_g) * (1.0 - lam_init)
    y = jnp.concatenate([y_conv, o.reshape(b, t, ATT_V)], axis=-1) @ w_o
    return y, k_new, v_new, new_conv


def run_layer(x, c, l, lam_init, norm1_g, norm2_g, w_ada, b_ada, w_in, conv_w, lambda_q1, lambda_k1,
              lambda_q2, lambda_k2, subln_g, w_o, w_mlp1, w_mlp2, conv_past, k_past, v_past, q_pos, k_pos):
    mod = jax.nn.silu(c) @ w_ada[l] + b_ada[l]
    sh1, sc1, g1, sh2, sc2, g2 = [m[:, None, :] for m in jnp.split(mod, 6, axis=-1)]
    h = rmsnorm(x, norm1_g[l]) * (1.0 + sc1) + sh1
    mix, k_new, v_new, conv_new = token_mix(h, w_in[l], conv_w[l], lambda_q1[l], lambda_k1[l],
                                            lambda_q2[l], lambda_k2[l], subln_g[l], w_o[l],
                                            conv_past, k_past, v_past, q_pos, k_pos, lam_init)
    x = x + g1 * mix
    h = rmsnorm(x, norm2_g[l]) * (1.0 + sc2) + sh2
    x = x + g2 * (jnp.square(jax.nn.relu(h @ w_mlp1[l])) @ w_mlp2[l])
    return x, k_new, v_new, conv_new


def setup_inputs(seed: int = 0) -> dict:
    key = jax.random.key(seed)
    ks = jax.random.split(key, 24)
    f32 = jnp.float32
    nrm = lambda k, shape, s: jax.random.normal(k, shape, f32) * s
    return {
        "x_prompt": nrm(ks[0], (BATCH, SEQ, D_MODEL), 1.0),
        "x_sample": nrm(ks[1], (DEC_BATCH, DEC_SEQ, D_MODEL), 1.0),
        "cache_k": nrm(ks[2], (DEPTH, DEC_BATCH, PAST_LEN, N_ATT_HEADS, 2 * DQK), 1.0),
        "cache_v": nrm(ks[3], (DEPTH, DEC_BATCH, PAST_LEN, N_ATT_HEADS, DV), 1.0),
        "state_conv": nrm(ks[4], (DEPTH, DEC_BATCH, CONV_K - 1, CONV_CH), 1.0),
        "c_prompt": nrm(ks[5], (BATCH, D_MODEL), 1.0),
        "c_sample": nrm(ks[6], (DEC_BATCH, D_MODEL), 1.0),
        "norm1_g": 1.0 + nrm(ks[7], (DEPTH, D_MODEL), 0.02),
        "norm2_g": 1.0 + nrm(ks[8], (DEPTH, D_MODEL), 0.02),
        "w_ada": nrm(ks[9], (DEPTH, D_MODEL, 6 * D_MODEL), 0.5 * D_MODEL ** -0.5),
        "b_ada": nrm(ks[10], (DEPTH, 6 * D_MODEL), 0.01),
        "w_in": nrm(ks[11], (DEPTH, D_MODEL, IN_WIDTH), D_MODEL ** -0.5),
        "conv_w": nrm(ks[12], (DEPTH, CONV_K, CONV_CH), CONV_K ** -0.5),
        "lambda_q1": nrm(ks[13], (DEPTH, DQK), 0.1),
        "lambda_k1": nrm(ks[14], (DEPTH, DQK), 0.1),
        "lambda_q2": nrm(ks[15], (DEPTH, DQK), 0.1),
        "lambda_k2": nrm(ks[16], (DEPTH, DQK), 0.1),
        "subln_g": 1.0 + nrm(ks[17], (DEPTH, DV), 0.02),
        "w_o": nrm(ks[18], (DEPTH, MIX_WIDTH, D_MODEL), MIX_WIDTH ** -0.5),
        "w_mlp1": nrm(ks[19], (DEPTH, D_MODEL, D_FF), D_MODEL ** -0.5),
        "w_mlp2": nrm(ks[20], (DEPTH, D_FF, D_MODEL), D_FF ** -0.5),
        "final_g": 1.0 + nrm(ks[21], (D_MODEL,), 0.02),
    }


def reference(x_prompt, x_sample, cache_k, cache_v, state_conv, c_prompt, c_sample,
              norm1_g, norm2_g, w_ada, b_ada, w_in, conv_w, lambda_q1, lambda_k1, lambda_q2, lambda_k2,
              subln_g, w_o, w_mlp1, w_mlp2, final_g):
    b_p, t_p = x_prompt.shape[0], x_prompt.shape[1]
    t_s = x_sample.shape[1]
    past = cache_k.shape[2]
    pos_p = jnp.arange(t_p, dtype=jnp.int32)
    q_pos_s = past + jnp.arange(t_s, dtype=jnp.int32)
    k_pos_s = jnp.arange(past + t_s, dtype=jnp.int32)
    weights = (norm1_g, norm2_g, w_ada, b_ada, w_in, conv_w, lambda_q1, lambda_k1,
               lambda_q2, lambda_k2, subln_g, w_o, w_mlp1, w_mlp2)
    xp, xs = x_prompt, x_sample
    kp_l, vp_l, cp_l, ksl, vsl, csl = [], [], [], [], [], []
    for l in range(DEPTH):
        lam_init = lambda_init_fn(l)
        zero_pad = jnp.zeros((b_p, CONV_K - 1, CONV_CH), xp.dtype)
        xp, kp, vp, cp = run_layer(xp, c_prompt, l, lam_init, *weights, zero_pad, None, None, pos_p, pos_p)
        xs, kn, vn, cn = run_layer(xs, c_sample, l, lam_init, *weights, state_conv[l], cache_k[l], cache_v[l],
                                   q_pos_s, k_pos_s)
        kp_l.append(kp); vp_l.append(vp); cp_l.append(cp)
        ksl.append(kn); vsl.append(vn); csl.append(cn)
    y_prompt = rmsnorm(xp, final_g)
    y_sample = rmsnorm(xs, final_g)
    return (y_prompt, y_sample, jnp.stack(kp_l), jnp.stack(vp_l), jnp.stack(cp_l),
            jnp.stack(ksl), jnp.stack(vsl), jnp.stack(csl))
```

```cpp
#include <hip/hip_runtime.h>
#include <hip/hip_cooperative_groups.h>
#include <cstdio>
#include <cstdint>
namespace cg = cooperative_groups;

constexpr int DM = 1024, NB_P = 8, T_P = 8192, NB_S = 32, T_S = 32, PAST = 1024;
constexpr int MP = NB_P * T_P, MS = NB_S * T_S, MT = MP + MS;
constexpr int INW = 3072, FF = 4096, HW = 512;
constexpr int KVS = 1088;
constexpr int KVROWS = MP + NB_S * KVS;
constexpr int NMOD = NB_P + NB_S;
constexpr float EPS = 1e-5f;
constexpr float LOG2E = 1.4426950408889634f;
constexpr float QSCALE = 0.125f * LOG2E;
constexpr size_t O_YP = 0, O_YS = (size_t)MP * DM, O_KP = O_YS + (size_t)MS * DM, O_VP = O_KP + (size_t)MP * HW, O_CP = O_VP + (size_t)MP * HW,
                 O_KS = O_CP + (size_t)NB_P * 2 * HW, O_VS = O_KS + (size_t)MS * HW, O_CS = O_VS + (size_t)MS * HW, O_END = O_CS + (size_t)NB_S * 2 * HW;

namespace pg8 {
#define PG8_LAS __attribute__((address_space(3)))
typedef unsigned short bf16_t;
typedef short bf16x8 __attribute__((ext_vector_type(8)));
typedef float f32x4 __attribute__((ext_vector_type(4)));
typedef unsigned u32x4 __attribute__((ext_vector_type(4)));
constexpr int BM = 256, BK = 64, HALF = 128, HTB = HALF * BK * 2  , STAGE_BYTES = 8 * HTB, NXCD = 8, WGM = 8;

__host__ __device__ __forceinline__ int lds_byte(int r, int c) { const int st = (r >> 4) * 2 + (c >> 5), rr = r & 15, cc = c & 31, ob = rr * 64 + cc * 2; return st * 1024 + (ob ^ (((ob >> 9) & 1) << 5)); }
__host__ __device__ __forceinline__ void stage_rc(int b, int& R, int& C) { const int st = b / 1024, sb = b % 1024, swz = sb ^ (((sb >> 9) & 1) << 5); R = (st >> 1) * 16 + swz / 64; C = (st & 1) * 32 + (swz % 64) / 2; }
__host__ __device__ __forceinline__ int perm32(int rho) { const int n = rho >> 4, i = rho & 15; return 8 * (i >> 2) + 4 * n + (i & 3); }

struct Unit { int pm, pn, k0; };
struct Gemm { const bf16_t* A; const bf16_t* Bt; int M, N, K, Kext; };

struct StaticOrder {
    int nM, nN, nwg, G, c;
    __host__ __device__ void init(int M, int N, int G_, int c_) { nM = M / BM; nN = N / BM; nwg = nM * nN; G = G_; c = c_; }
    __host__ __device__ bool next(int i, Unit& u) const {
        const long L = (long)i * G + c; if (L >= nwg) return false;
        int wgid = (int)L; { const int q = nwg / NXCD, r = nwg % NXCD, xcd = wgid % NXCD, off = wgid / NXCD; wgid = (xcd < r ? xcd * (q + 1) : r * (q + 1) + (xcd - r) * q) + off; }
        const int nig = WGM * nN, gid = wgid / nig, fm = gid * WGM, gsz = (nM - fm) < WGM ? (nM - fm) : WGM;
        u.pm = fm + ((wgid % nig) % gsz); u.pn = (wgid % nig) / gsz; u.k0 = 0; return true;
    }
    __device__ __forceinline__ void a_ready(const Unit&) const {}
    __device__ __forceinline__ void done(const Unit&) const {}
};

struct SplitOrder {
    int nM, nN, nS, ksz, G, c;
    __host__ __device__ bool next(int i, Unit& u) const { const int L = i * G + c; if (L >= nM * nN * nS) return false; u.pm = L % nM; u.pn = (L / nM) % nN; u.k0 = (L / (nM * nN)) * ksz; return true; }
    __device__ __forceinline__ void a_ready(const Unit&) const {}
    __device__ __forceinline__ void done(const Unit&) const {}
};

__device__ __forceinline__ unsigned cvt_pk_bf16(float lo, float hi) { unsigned r; asm volatile("v_cvt_pk_bf16_f32 %0, %1, %2" : "=v"(r) : "v"(lo), "v"(hi)); return r; }
__device__ __forceinline__ u32x4 pack8(f32x4 v0, f32x4 v1) { u32x4 w; w.x = cvt_pk_bf16(v0[0], v0[1]); w.y = cvt_pk_bf16(v0[2], v0[3]); w.z = cvt_pk_bf16(v1[0], v1[1]); w.w = cvt_pk_bf16(v1[2], v1[3]); return w; }

__device__ __forceinline__ float fq_sum(float v) {
    auto a = __builtin_amdgcn_permlane16_swap(__float_as_uint(v), __float_as_uint(v), false, false); v = __uint_as_float(a[0]) + __uint_as_float(a[1]);
    auto b = __builtin_amdgcn_permlane32_swap(__float_as_uint(v), __float_as_uint(v), false, false); return __uint_as_float(b[0]) + __uint_as_float(b[1]); }
struct EpiIn {
    static constexpr bool PERM = true, AFTER_DRAIN = false;
    bf16_t *BG, *CG, *UG, *QB, *KB, *VB; float* out; unsigned* maxbuf;
    __device__ __forceinline__ void operator()(const f32x4 (&acc)[2][2][4][2], const Unit& u, int wr, int wc, int fr, int fq) const {
        { int t2 = threadIdx.x; asm volatile("" : "+v"(t2)); const int w2 = t2 >> 6, l2 = t2 & 63; wr = w2 >> 2; wc = w2 & 3; fr = l2 & 15; fq = l2 >> 4; }
        const int seg = u.pn >> 1, col0 = (u.pn & 1) * 256 + wc * 32 + 8 * fq, row0 = u.pm * BM + wr * 64 + fr;
        const bool smp = u.pm >= (MP / BM);
        if (!smp && (seg == 3 || seg == 4)) {
            const float sc2 = seg == 3 ? QSCALE * QSCALE : 1.f; float mx[2] = {0.f, 0.f};
#pragma unroll
            for (int ai = 0; ai < 2; ++ai)
#pragma unroll
                for (int m = 0; m < 4; ++m)
#pragma unroll
                    for (int bj = 0; bj < 2; ++bj) { const f32x4 v0 = acc[ai][bj][m][0], v1 = acc[ai][bj][m][1];
                        float ss = (v0[0] * v0[0] + v0[1] * v0[1]) + (v0[2] * v0[2] + v0[3] * v0[3]) + (v1[0] * v1[0] + v1[1] * v1[1]) + (v1[2] * v1[2] + v1[3] * v1[3]);
                        ss = fq_sum(ss); mx[bj] = fmaxf(mx[bj], ss * sc2); }
#pragma unroll
            for (int bj = 0; bj < 2; ++bj)
                if (fq == 0) atomicMax(maxbuf + (seg == 4 ? 128 : 0) + (u.pm >> 5) * 16 + (u.pn & 1) * 8 + bj * 4 + wc, __float_as_uint(mx[bj]));
        }
        if (seg < 4) {
            bf16_t* base = seg == 0 ? BG : seg == 1 ? CG : seg == 2 ? UG : QB; const float sc = seg == 3 ? QSCALE : 1.f;
#pragma unroll
            for (int ai = 0; ai < 2; ++ai)
#pragma unroll
                for (int m = 0; m < 4; ++m) { bf16_t* rowp = base + (size_t)(row0 + ai * HALF + m * 16) * HW + col0;
#pragma unroll
                    for (int bj = 0; bj < 2; ++bj) *(u32x4*)(rowp + bj * HALF) = pack8(acc[ai][bj][m][0] * sc, acc[ai][bj][m][1] * sc); }
        } else {
            bf16_t* kvb = seg == 4 ? KB : VB;
            float* ob = out + (smp ? (seg == 4 ? O_KS : O_VS) : (seg == 4 ? O_KP : O_VP));
#pragma unroll
            for (int ai = 0; ai < 2; ++ai)
#pragma unroll
                for (int m = 0; m < 4; ++m) { const int row = row0 + ai * HALF + m * 16; const int rs = row - MP;
                    const size_t orow = smp ? (size_t)rs : (size_t)row;
                    const size_t kvrow = smp ? (size_t)(MP + (rs >> 5) * KVS + PAST + (rs & 31)) : (size_t)row;
                    float* op = ob + orow * HW + col0; bf16_t* kp = kvb + kvrow * HW + col0;
#pragma unroll
                    for (int bj = 0; bj < 2; ++bj) { const f32x4 v0 = acc[ai][bj][m][0], v1 = acc[ai][bj][m][1];
                        __builtin_nontemporal_store(v0, (f32x4*)(op + bj * HALF)); __builtin_nontemporal_store(v1, (f32x4*)(op + bj * HALF + 4)); *(u32x4*)(kp + bj * HALF) = pack8(v0, v1); } }
        }
    }
};
struct EpiResGate {
    static constexpr bool PERM = true, AFTER_DRAIN = false;
    const float* res_p; const float* res_s; float* out; const float* gate;
    __device__ __forceinline__ void operator()(const f32x4 (&acc)[2][2][4][2], const Unit& u, int wr, int wc, int fr, int fq) const {
        { int t2 = threadIdx.x; asm volatile("" : "+v"(t2)); const int w2 = t2 >> 6, l2 = t2 & 63; wr = w2 >> 2; wc = w2 & 3; fr = l2 & 15; fq = l2 >> 4; }
        const int col0 = u.pn * BM + wc * 32 + 8 * fq, row0 = u.pm * BM + wr * 64 + fr;
#pragma unroll
        for (int ai = 0; ai < 2; ++ai)
#pragma unroll
            for (int m = 0; m < 4; ++m) { const int row = row0 + ai * HALF + m * 16;
                const int mrow = row < MP ? (row >> 13) : NB_P + ((row - MP) >> 5);
                const float* rp = (row < MP ? res_p + (size_t)row * DM : res_s + (size_t)(row - MP) * DM) + col0;
                const float* gp = gate + (size_t)mrow * (6 * DM) + col0; float* op = out + (size_t)row * DM + col0;
#pragma unroll
                for (int bj = 0; bj < 2; ++bj) {
                    const f32x4 g0 = *(const f32x4*)(gp + bj * HALF), g1 = *(const f32x4*)(gp + bj * HALF + 4);
                    const f32x4 x0 = *(const f32x4*)(rp + bj * HALF), x1 = *(const f32x4*)(rp + bj * HALF + 4);
                    *(f32x4*)(op + bj * HALF) = x0 + g0 * acc[ai][bj][m][0]; *(f32x4*)(op + bj * HALF + 4) = x1 + g1 * acc[ai][bj][m][1]; }
                if (m & 1) asm volatile("" ::: "memory"); }
    }
};
struct EpiRelu2 {
    static constexpr bool PERM = true, AFTER_DRAIN = false;
    bf16_t* O; int ldc;
    __device__ __forceinline__ void operator()(const f32x4 (&acc)[2][2][4][2], const Unit& u, int wr, int wc, int fr, int fq) const {
        { int t2 = threadIdx.x; asm volatile("" : "+v"(t2)); const int w2 = t2 >> 6, l2 = t2 & 63; wr = w2 >> 2; wc = w2 & 3; fr = l2 & 15; fq = l2 >> 4; }
        const int col0 = u.pn * BM + wc * 32 + 8 * fq, row0 = u.pm * BM + wr * 64 + fr;
#pragma unroll
        for (int ai = 0; ai < 2; ++ai)
#pragma unroll
            for (int m = 0; m < 4; ++m) { bf16_t* rowp = O + (size_t)(row0 + ai * HALF + m * 16) * ldc + col0;
#pragma unroll
                for (int bj = 0; bj < 2; ++bj) { f32x4 v0 = acc[ai][bj][m][0], v1 = acc[ai][bj][m][1];
#pragma unroll
                    for (int e = 0; e < 4; ++e) { const float a = fmaxf(v0[e], 0.f), b = fmaxf(v1[e], 0.f); v0[e] = a * a; v1[e] = b * b; }
                    *(u32x4*)(rowp + bj * HALF) = pack8(v0, v1); } }
    }
};

struct EpiResGate2 {
    static constexpr bool PERM = true, AFTER_DRAIN = false;
    const float* res_p; const float* res_s; float* out; const float* gate; const float* sc2; const float* n2g; bf16_t* XN; float* rowss;
    __device__ __forceinline__ void operator()(const f32x4 (&acc)[2][2][4][2], const Unit& u, int wr, int wc, int fr, int fq) const {
        { int t2 = threadIdx.x; asm volatile("" : "+v"(t2)); const int w2 = t2 >> 6, l2 = t2 & 63; wr = w2 >> 2; wc = w2 & 3; fr = l2 & 15; fq = l2 >> 4; }
        const int col0 = u.pn * BM + wc * 32 + 8 * fq, row0 = u.pm * BM + wr * 64 + fr;
#pragma unroll
        for (int ai = 0; ai < 2; ++ai)
#pragma unroll
            for (int m = 0; m < 4; ++m) { const int row = row0 + ai * HALF + m * 16;
                const int mrow = row < MP ? (row >> 13) : NB_P + ((row - MP) >> 5);
                const float* rp = (row < MP ? res_p + (size_t)row * DM : res_s + (size_t)(row - MP) * DM) + col0;
                const float* gp = gate + (size_t)mrow * (6 * DM) + col0; const float* cp = sc2 + (size_t)mrow * (6 * DM) + col0; float* op = out + (size_t)row * DM + col0;
                bf16_t* xp = XN + (size_t)row * DM + col0; float ss = 0.f;
#pragma unroll
                for (int bj = 0; bj < 2; ++bj) {
                    const f32x4 g0 = *(const f32x4*)(gp + bj * HALF), g1 = *(const f32x4*)(gp + bj * HALF + 4);
                    const f32x4 x0 = *(const f32x4*)(rp + bj * HALF), x1 = *(const f32x4*)(rp + bj * HALF + 4);
                    const f32x4 y0 = x0 + g0 * acc[ai][bj][m][0], y1 = x1 + g1 * acc[ai][bj][m][1];
                    *(f32x4*)(op + bj * HALF) = y0; *(f32x4*)(op + bj * HALF + 4) = y1;
                    ss += (y0[0] * y0[0] + y0[1] * y0[1]) + (y0[2] * y0[2] + y0[3] * y0[3]) + (y1[0] * y1[0] + y1[1] * y1[1]) + (y1[2] * y1[2] + y1[3] * y1[3]);
                    const f32x4 n0 = *(const f32x4*)(n2g + col0 + bj * HALF), n1 = *(const f32x4*)(n2g + col0 + bj * HALF + 4);
                    const f32x4 c0 = *(const f32x4*)(cp + bj * HALF), c1 = *(const f32x4*)(cp + bj * HALF + 4);
                    *(u32x4*)(xp + bj * HALF) = pack8(y0 * n0 * (c0 + 1.f), y1 * n1 * (c1 + 1.f)); }
                ss = fq_sum(ss);
                if (fq == 0) unsafeAtomicAdd(rowss + row, ss);
                asm volatile("" ::: "memory"); }
    }
};
struct EpiRelu2N {
    static constexpr bool PERM = true, AFTER_DRAIN = false;
    bf16_t* O; int ldc; const float* rowss; const float* bias2;
    __device__ __forceinline__ void operator()(const f32x4 (&acc)[2][2][4][2], const Unit& u, int wr, int wc, int fr, int fq) const {
        { int t2 = threadIdx.x; asm volatile("" : "+v"(t2)); const int w2 = t2 >> 6, l2 = t2 & 63; wr = w2 >> 2; wc = w2 & 3; fr = l2 & 15; fq = l2 >> 4; }
        const int col0 = u.pn * BM + wc * 32 + 8 * fq, row0 = u.pm * BM + wr * 64 + fr;
#pragma unroll
        for (int ai = 0; ai < 2; ++ai)
#pragma unroll
            for (int m = 0; m < 4; ++m) { const int row = row0 + ai * HALF + m * 16; const int mrow = row < MP ? (row >> 13) : NB_P + ((row - MP) >> 5);
                const float rstd = 1.f / sqrtf(rowss[row] * (1.f / DM) + EPS);
                const float* bp = bias2 + (size_t)mrow * FF + col0; bf16_t* rowp = O + (size_t)row * ldc + col0;
#pragma unroll
                for (int bj = 0; bj < 2; ++bj) { f32x4 v0 = acc[ai][bj][m][0] * rstd + *(const f32x4*)(bp + bj * HALF), v1 = acc[ai][bj][m][1] * rstd + *(const f32x4*)(bp + bj * HALF + 4);
#pragma unroll
                    for (int e = 0; e < 4; ++e) { const float a = fmaxf(v0[e], 0.f), b = fmaxf(v1[e], 0.f); v0[e] = a * a; v1[e] = b * b; }
                    *(u32x4*)(rowp + bj * HALF) = pack8(v0, v1); } }
    }
};
struct EpiPartial {
    static constexpr bool PERM = true, AFTER_DRAIN = false;
    float* part; int ksz, nrows, ld;
    __device__ __forceinline__ void operator()(const f32x4 (&acc)[2][2][4][2], const Unit& u, int wr, int wc, int fr, int fq) const {
        { int t2 = threadIdx.x; asm volatile("" : "+v"(t2)); const int w2 = t2 >> 6, l2 = t2 & 63; wr = w2 >> 2; wc = w2 & 3; fr = l2 & 15; fq = l2 >> 4; }
        const int col0 = u.pn * BM + wc * 32 + 8 * fq, row0 = u.pm * BM + wr * 64 + fr;
        float* pb = part + (size_t)(u.k0 / ksz) * nrows * ld;
#pragma unroll
        for (int ai = 0; ai < 2; ++ai)
#pragma unroll
            for (int m = 0; m < 4; ++m) { float* op = pb + (size_t)(row0 + ai * HALF + m * 16) * ld + col0;
#pragma unroll
                for (int bj = 0; bj < 2; ++bj) { *(f32x4*)(op + bj * HALF) = acc[ai][bj][m][0]; *(f32x4*)(op + bj * HALF + 4) = acc[ai][bj][m][1]; } }
    }
};

template <class Epi, class Sched, bool ALIGN_EPI = false, bool SP2 = false>
__device__ __forceinline__ void gemm_phase(PG8_LAS unsigned char* lds, const Gemm g, const Sched& S, const Epi& E) {
    int tid = threadIdx.x; asm volatile("" : "+v"(tid));
    const int wid = __builtin_amdgcn_readfirstlane(tid >> 6), lane = tid & 63, wr = wid >> 2, wc = wid & 3, fr = lane & 15, fq = lane >> 4;
    const int K = g.K, nt = (g.Kext ? g.Kext : K) / BK;
    unsigned voffA[2], voffB[2];
#pragma unroll
    for (int i = 0; i < 2; ++i) { int R, C; stage_rc(tid * 16 + i * 8192, R, C); const int Rb = Epi::PERM ? ((R & ~31) + perm32(R & 31)) : R;
        voffA[i] = (unsigned)(R * K + C) * 2u; voffB[i] = (unsigned)(Rb * K + C) * 2u; }
    const size_t kstep = (size_t)(BK * 2);
    const size_t hstep = (size_t)HALF * K * 2;
    const size_t tstep = 2 * hstep;
    const unsigned ldsw = (unsigned)wid * 1024u;
    const int aoff = lds_byte(wr * 64 + fr, fq * 8), boff = lds_byte(wc * 32 + fr, fq * 8);
#define PG8_SA(b, h) (((b) * 2 + (h)) * HTB)
#define PG8_SB(b, h) ((4 + (b) * 2 + (h)) * HTB)
#define PG8_STAGE(bufoff, gbase, voff) do { _Pragma("unroll") for (int _i = 0; _i < 2; ++_i) \
        __builtin_amdgcn_global_load_lds((const unsigned*)((const char*)(gbase) + (voff)[_i]), (PG8_LAS unsigned*)(lds + (bufoff) + ldsw + _i * 8192), 16, 0, 0); } while (0)
#define PG8_LDA(dst, b, h) do { _Pragma("unroll") for (int m = 0; m < 4; ++m) _Pragma("unroll") for (int k = 0; k < 2; ++k) dst[m][k] = *(const PG8_LAS bf16x8*)(lds + PG8_SA(b, h) + aoff + m * 2048 + k * 1024); } while (0)
#define PG8_LDB(dst, b, h) do { _Pragma("unroll") for (int n = 0; n < 2; ++n) _Pragma("unroll") for (int k = 0; k < 2; ++k) dst[n][k] = *(const PG8_LAS bf16x8*)(lds + PG8_SB(b, h) + boff + n * 2048 + k * 1024); } while (0)
#define PG8_MMA(ai, bj, At, Bt) do { __builtin_amdgcn_s_setprio(1); _Pragma("unroll") for (int m = 0; m < 4; ++m) _Pragma("unroll") for (int n = 0; n < 2; ++n) _Pragma("unroll") for (int k = 0; k < 2; ++k) \
        acc[ai][bj][m][n] = __builtin_amdgcn_mfma_f32_16x16x32_bf16(Bt[n][k], At[m][k], acc[ai][bj][m][n], 0, 0, 0); __builtin_amdgcn_s_setprio(0); } while (0)
#define PG8_WAIT_V(n) asm volatile("s_waitcnt vmcnt(" #n ")" ::: "memory")
#define PG8_WAIT_L(n) asm volatile("s_waitcnt lgkmcnt(" #n ")" ::: "memory")
#define PG8_BAR __builtin_amdgcn_s_barrier()
#define PG8_SCHED __builtin_amdgcn_sched_barrier(0)
    Unit cur, nxt; int ui = 0;
    if (!S.next(0, cur)) return;
    f32x4 acc[2][2][4][2];
#pragma unroll
    for (int a = 0; a < 2; ++a)
#pragma unroll
        for (int b = 0; b < 2; ++b)
#pragma unroll
            for (int m = 0; m < 4; ++m)
#pragma unroll
                for (int n = 0; n < 2; ++n) acc[a][b][m][n] = (f32x4){0.f, 0.f, 0.f, 0.f};
    bf16x8 At[4][2], B0[2][2], B1[2][2];
    const char* cA = (const char*)g.A + (size_t)cur.pm * tstep + (size_t)cur.k0 * 2; const char* cB = (const char*)g.Bt + (size_t)cur.pn * tstep + (size_t)cur.k0 * 2;
    S.a_ready(cur);
    if constexpr (SP2) {
        PG8_STAGE(PG8_SB(0, 0), cB, voffB); PG8_STAGE(PG8_SB(0, 1), cB + hstep, voffB); PG8_STAGE(PG8_SA(0, 0), cA, voffA); PG8_STAGE(PG8_SA(0, 1), cA + hstep, voffA);
        if (wr == 1) PG8_BAR;
        PG8_WAIT_V(2); PG8_BAR;
        PG8_STAGE(PG8_SB(1, 0), cB + kstep, voffB); PG8_STAGE(PG8_SA(1, 0), cA + kstep, voffA); PG8_STAGE(PG8_SB(1, 1), cB + hstep + kstep, voffB);
        PG8_WAIT_V(6); PG8_BAR;
    } else {
        PG8_STAGE(PG8_SB(0, 0), cB, voffB); PG8_STAGE(PG8_SA(0, 0), cA, voffA); PG8_STAGE(PG8_SB(0, 1), cB + hstep, voffB); PG8_STAGE(PG8_SA(0, 1), cA + hstep, voffA);
        if (wr == 1) PG8_BAR;
        PG8_WAIT_V(4); PG8_BAR;
        PG8_STAGE(PG8_SB(1, 0), cB + kstep, voffB); PG8_STAGE(PG8_SA(1, 0), cA + kstep, voffA); PG8_STAGE(PG8_SB(1, 1), cB + hstep + kstep, voffB);
        PG8_WAIT_V(6); PG8_BAR;
    }
    for (;;) {
        const bool has_next = S.next(ui + 1, nxt);
        const char* nA = has_next ? (const char*)g.A + (size_t)nxt.pm * tstep + (size_t)nxt.k0 * 2 : cA; const char* nB = has_next ? (const char*)g.Bt + (size_t)nxt.pn * tstep + (size_t)nxt.k0 * 2 : cB;
        for (int t = 0; t < nt; t += 2) {
            const bool last = (t == nt - 2);
            const char* a1 = cA + (size_t)(t + 1) * kstep;
            const char* a2 = last ? nA : cA + (size_t)(t + 2) * kstep; const char* b2 = last ? nB : cB + (size_t)(t + 2) * kstep;
            const char* a3 = a2 + kstep; const char* b3 = b2 + kstep;
            if (last && has_next) S.a_ready(nxt);
            if constexpr (SP2) {
            PG8_LDB(B0, 0, 0); PG8_LDB(B1, 0, 1); PG8_SCHED; PG8_LDA(At, 0, 0); PG8_STAGE(PG8_SA(1, 1), a1 + hstep, voffA);
            PG8_WAIT_V(8); PG8_WAIT_L(0); PG8_BAR; PG8_MMA(0, 0, At, B0); PG8_MMA(0, 1, At, B1); PG8_BAR; PG8_SCHED;
            PG8_LDA(At, 0, 1); PG8_STAGE(PG8_SB(0, 0), b2, voffB); PG8_STAGE(PG8_SB(0, 1), b2 + hstep, voffB); PG8_STAGE(PG8_SA(0, 0), a2, voffA);
            PG8_WAIT_V(8); PG8_WAIT_L(0); PG8_BAR; PG8_MMA(1, 0, At, B0); PG8_MMA(1, 1, At, B1); PG8_BAR; PG8_SCHED;
            PG8_LDB(B0, 1, 0); PG8_LDB(B1, 1, 1); PG8_SCHED; PG8_LDA(At, 1, 0); PG8_STAGE(PG8_SA(0, 1), a2 + hstep, voffA);
            PG8_WAIT_V(8); PG8_WAIT_L(0); PG8_BAR; PG8_MMA(0, 0, At, B0); PG8_MMA(0, 1, At, B1); PG8_BAR; PG8_SCHED;
            PG8_LDA(At, 1, 1); PG8_STAGE(PG8_SB(1, 0), b3, voffB); PG8_STAGE(PG8_SB(1, 1), b3 + hstep, voffB); PG8_STAGE(PG8_SA(1, 0), a3, voffA);
            PG8_WAIT_V(8); PG8_WAIT_L(0); PG8_BAR; PG8_MMA(1, 0, At, B0); PG8_MMA(1, 1, At, B1); PG8_BAR; PG8_SCHED;
            } else {
            PG8_LDB(B0, 0, 0); PG8_SCHED; PG8_LDA(At, 0, 0); PG8_STAGE(PG8_SA(1, 1), a1 + hstep, voffA);
            PG8_WAIT_L(8); PG8_BAR; PG8_WAIT_L(0); PG8_MMA(0, 0, At, B0); PG8_BAR; PG8_SCHED;
            PG8_LDB(B1, 0, 1); PG8_STAGE(PG8_SB(0, 0), b2, voffB);
            PG8_BAR; PG8_WAIT_L(0); PG8_MMA(0, 1, At, B1); PG8_BAR;
            PG8_LDA(At, 0, 1); PG8_STAGE(PG8_SA(0, 0), a2, voffA);
            PG8_BAR; PG8_WAIT_L(0); PG8_MMA(1, 0, At, B0); PG8_BAR; PG8_SCHED;
            PG8_STAGE(PG8_SB(0, 1), b2 + hstep, voffB);
            PG8_WAIT_V(6); PG8_BAR; PG8_MMA(1, 1, At, B1); PG8_BAR;
            PG8_LDB(B0, 1, 0); PG8_SCHED; PG8_LDA(At, 1, 0); PG8_STAGE(PG8_SA(0, 1), a2 + hstep, voffA);
            PG8_WAIT_L(8); PG8_BAR; PG8_WAIT_L(0); PG8_MMA(0, 0, At, B0); PG8_BAR; PG8_SCHED;
            PG8_LDB(B1, 1, 1); PG8_STAGE(PG8_SB(1, 0), b3, voffB);
            PG8_BAR; PG8_WAIT_L(0); PG8_MMA(0, 1, At, B1); PG8_BAR;
            PG8_LDA(At, 1, 1); PG8_STAGE(PG8_SA(1, 0), a3, voffA);
            PG8_BAR; PG8_WAIT_L(0); PG8_MMA(1, 0, At, B0); PG8_BAR; PG8_SCHED;
            PG8_STAGE(PG8_SB(1, 1), b3 + hstep, voffB);
            PG8_WAIT_V(6); PG8_BAR; PG8_MMA(1, 1, At, B1); PG8_BAR;
            }
        }
        if constexpr (ALIGN_EPI) { if (wr == 0) PG8_BAR; }
        if constexpr (!Epi::AFTER_DRAIN) { E(acc, cur, wr, wc, fr, fq); S.done(cur); }
        if (!has_next) break;
#pragma unroll
        for (int a = 0; a < 2; ++a)
#pragma unroll
            for (int b = 0; b < 2; ++b)
#pragma unroll
                for (int m = 0; m < 4; ++m)
#pragma unroll
                    for (int n = 0; n < 2; ++n) acc[a][b][m][n] = (f32x4){0.f, 0.f, 0.f, 0.f};
        cur = nxt; cA = nA; cB = nB; ++ui;
        if constexpr (ALIGN_EPI) { if (wr == 1) PG8_BAR; }
    }
    PG8_WAIT_V(0);
    if constexpr (!ALIGN_EPI) { if (wr == 0) PG8_BAR; }
    PG8_BAR;
    if constexpr (Epi::AFTER_DRAIN) { E.fused(acc, cur, wr, wc, fr, fq, lds, wid, lane); S.done(cur); }
#undef PG8_SA
#undef PG8_SB
#undef PG8_STAGE
#undef PG8_LDA
#undef PG8_LDB
#undef PG8_MMA
#undef PG8_WAIT_V
#undef PG8_WAIT_L
#undef PG8_BAR
#undef PG8_SCHED
}
}

namespace att {
#define ALAS __attribute__((address_space(3)))
typedef unsigned short bf16_t;
typedef short bf16x8 __attribute__((ext_vector_type(8)));
typedef short s16x4 __attribute__((ext_vector_type(4)));
typedef float f32x16 __attribute__((ext_vector_type(16)));
typedef float f32x4 __attribute__((ext_vector_type(4)));
typedef float f32x2_t __attribute__((ext_vector_type(2)));
typedef __bf16 bf16x2_t __attribute__((ext_vector_type(2)));
typedef unsigned u32x4 __attribute__((ext_vector_type(4)));
typedef unsigned u32x2 __attribute__((ext_vector_type(2)));
typedef short v4i16_t __attribute__((ext_vector_type(4)));
constexpr int TILE_B = 16384;
constexpr int STG_K = 0, STG_V = 2 * TILE_B, STG_B = 4 * TILE_B;
__device__ __forceinline__ int crow(int r, int h) { return (r & 3) + 8 * (r >> 2) + 4 * h; }
__device__ __forceinline__ unsigned cvtpk(float lo, float hi) { f32x2_t v = {lo, hi}; bf16x2_t b = __builtin_convertvector(v, bf16x2_t); return __builtin_bit_cast(unsigned, b); }
__device__ __forceinline__ float half_max(float v) { auto rr = __builtin_amdgcn_permlane32_swap(__float_as_uint(v), __float_as_uint(v), false, false); return fmaxf(__uint_as_float(rr[0]), __uint_as_float(rr[1])); }
__device__ __forceinline__ float half_sum(float v) { auto rr = __builtin_amdgcn_permlane32_swap(__float_as_uint(v), __float_as_uint(v), false, false); return __uint_as_float(rr[0]) + __uint_as_float(rr[1]); }
__device__ __forceinline__ s16x4 vtr(const ALAS unsigned char* p) { return __builtin_bit_cast(s16x4, __builtin_amdgcn_ds_read_tr16_b64_v4i16((ALAS v4i16_t*)p)); }

struct UnitDesc { const bf16_t* Q; const bf16_t* K; const bf16_t* V; bf16_t* O; int q0pos, nvalid, kv_len, s_hi, s_lo; float slope2; };

__device__ __forceinline__ void attn_unit(ALAS unsigned char* lds, const UnitDesc d, const float lam, const float* __restrict__ subg) {
    int tid = threadIdx.x; asm volatile("" : "+v"(tid));
    const int lane = tid & 63, w = __builtin_amdgcn_readfirstlane(tid >> 6), c = w >> 2, j = w & 3, r32 = lane & 31, hh = lane >> 5;
    const bool active = (32 * j < d.nvalid);
    const int qw0 = d.q0pos + 32 * j;
    const int td = active ? (qw0 >> 6) : -1;
    const int lrow = lane >> 4; const unsigned fsw = (((unsigned)lrow & 3u) << 2) | ((unsigned)w & 3u); const int gch = (int)(((unsigned)lane & 15u) ^ fsw);
    const bf16_t* kg = d.K + (size_t)(4 * w + lrow) * HW + gch * 8;
    const bf16_t* vg = d.V + (size_t)(4 * w + lrow) * HW + gch * 8;
#define ATT_DMA(s_, buf_) do { const size_t go_ = (size_t)(s_) * 128 * HW; ALAS unsigned char* lb_ = lds + (buf_) * STG_B + w * 1024; \
        _Pragma("unroll") for (int i_ = 0; i_ < 4; ++i_) { \
        __builtin_amdgcn_global_load_lds((const unsigned*)(kg + go_ + (size_t)i_ * 32 * HW), (ALAS unsigned*)(lb_ + STG_K + i_ * 8192), 16, 0, 0); \
        __builtin_amdgcn_global_load_lds((const unsigned*)(vg + go_ + (size_t)i_ * 32 * HW), (ALAS unsigned*)(lb_ + STG_V + i_ * 8192), 16, 0, 0); } } while (0)
    bf16x8 qf[4];
#pragma unroll
    for (int s = 0; s < 4; ++s) { if (active) qf[s] = *(const bf16x8*)(d.Q + (size_t)(32 * j + r32) * HW + c * 64 + 16 * s + 8 * hh); else qf[s] = (bf16x8){0, 0, 0, 0, 0, 0, 0, 0}; }
    unsigned koff[4];
    { const unsigned f = ((r32 & 3u) << 2) | ((r32 >> 2) & 3u);
#pragma unroll
      for (int s = 0; s < 4; ++s) koff[s] = 256u * r32 + 16u * (((unsigned)(8 * c + 2 * s + hh)) ^ f); }
    unsigned voff[2][4];
    { const unsigned qq = (lane & 15) >> 2, p = lane & 3, blk = (lane >> 4) & 1;
#pragma unroll
      for (int tt = 0; tt < 2; ++tt)
#pragma unroll
          for (int c4 = 0; c4 < 4; ++c4)
              voff[tt][c4] = 256u * (8 * tt + 4 * hh + qq) + 16u * ((((unsigned)c4 ^ qq) << 2) | (((2 * blk + (p >> 1)) ^ (unsigned)(2 * tt + hh)) & 3u)) + 8u * (p & 1); }
    float mref = 0.f, lsum = 0.f;
    f32x16 o[4];
#pragma unroll
    for (int c4 = 0; c4 < 4; ++c4)
#pragma unroll
        for (int i = 0; i < 16; ++i) o[c4][i] = 0.f;

    const int NI = d.s_hi - d.s_lo + 1;
    ATT_DMA(d.s_lo, 0);
    for (int it = 0; it < NI; ++it) {
        const int sg = d.s_lo + it;
        asm volatile("s_waitcnt vmcnt(0)" ::: "memory"); __syncthreads();
        if (it + 1 < NI) ATT_DMA(sg + 1, (it + 1) & 1);
        const ALAS unsigned char* Sb = lds + (it & 1) * STG_B;
#pragma unroll
        for (int tau = 0; tau < 2; ++tau) {
            const int t = 2 * sg + tau;
            if (t <= td) {
                const ALAS unsigned char* Kb = Sb + STG_K + tau * TILE_B; const ALAS unsigned char* Vb = Sb + STG_V + tau * TILE_B;
                f32x16 s0, s1;
                if (t == td) {
                    const int qpos = qw0 + r32; const float rc = d.slope2 * (float)r32 - mref;
#pragma unroll
                    for (int i = 0; i < 16; ++i) { const int k0 = 64 * t + crow(i, hh), k1 = k0 + 32;
                        const int d0 = qpos - k0, d1 = qpos - k1;
                        s0[i] = k0 < d.kv_len ? rc - d.slope2 * (float)(d0 < 0 ? -d0 : d0) : -1e30f;
                        s1[i] = k1 < d.kv_len ? rc - d.slope2 * (float)(d1 < 0 ? -d1 : d1) : -1e30f; }
                } else {
                    const float b0 = d.slope2 * (float)(64 * t - qw0 + 4 * hh) - mref, b1 = b0 + 32.f * d.slope2;
#pragma unroll
                    for (int i = 0; i < 16; ++i) { const float ci = (float)((i & 3) + 8 * (i >> 2)); s0[i] = __builtin_fmaf(d.slope2, ci, b0); s1[i] = __builtin_fmaf(d.slope2, ci, b1); }
                }
                bf16x8 kf[8];
#pragma unroll
                for (int s = 0; s < 4; ++s) { kf[2 * s] = *(const ALAS bf16x8*)(Kb + koff[s]); kf[2 * s + 1] = *(const ALAS bf16x8*)(Kb + koff[s] + 8192); }
                __builtin_amdgcn_sched_barrier(0);
#pragma unroll
                for (int s = 0; s < 4; ++s) {
                    s0 = __builtin_amdgcn_mfma_f32_32x32x16_bf16(kf[2 * s], qf[s], s0, 0, 0, 0);
                    s1 = __builtin_amdgcn_mfma_f32_32x32x16_bf16(kf[2 * s + 1], qf[s], s1, 0, 0, 0);
                }
                s16x4 vl[2][4], vh[2][4];
#define ATT_VLD(bsel_, ks_) do { _Pragma("unroll") for (int c4 = 0; c4 < 4; ++c4) { vl[bsel_][c4] = vtr(Vb + voff[0][c4] + 4096 * (ks_)); vh[bsel_][c4] = vtr(Vb + voff[1][c4] + 4096 * (ks_)); } } while (0)
                ATT_VLD(0, 0);
                __builtin_amdgcn_sched_barrier(0);
                float pm = 0.f, ps = 0.f;
#pragma unroll
                for (int i = 0; i < 16; ++i) { s0[i] = __builtin_amdgcn_exp2f(s0[i]); s1[i] = __builtin_amdgcn_exp2f(s1[i]); }
#pragma unroll
                for (int i = 0; i < 16; i += 2) pm = fmaxf(fmaxf(pm, fmaxf(s0[i], s0[i + 1])), fmaxf(s1[i], s1[i + 1]));
                if (__builtin_expect(__any(pm > 256.f), 0)) {
                    pm = half_max(pm);
                    const float dl = pm > 1.f ? ceilf(__builtin_amdgcn_logf(pm)) : 0.f, f = __builtin_amdgcn_exp2f(-dl);
                    mref += dl; lsum *= f;
#pragma unroll
                    for (int i = 0; i < 16; ++i) { s0[i] *= f; s1[i] *= f; }
#pragma unroll
                    for (int c4 = 0; c4 < 4; ++c4)
#pragma unroll
                        for (int i = 0; i < 16; ++i) o[c4][i] *= f;
                }
#pragma unroll
                for (int i = 0; i < 16; ++i) ps += s0[i] + s1[i];
                lsum += ps;
                bf16x8 pf[4];
#pragma unroll
                for (int s = 0; s < 2; ++s) {
                    u32x4 a, b;
                    a.x = cvtpk(s0[8 * s], s0[8 * s + 1]); a.y = cvtpk(s0[8 * s + 2], s0[8 * s + 3]); a.z = cvtpk(s0[8 * s + 4], s0[8 * s + 5]); a.w = cvtpk(s0[8 * s + 6], s0[8 * s + 7]);
                    b.x = cvtpk(s1[8 * s], s1[8 * s + 1]); b.y = cvtpk(s1[8 * s + 2], s1[8 * s + 3]); b.z = cvtpk(s1[8 * s + 4], s1[8 * s + 5]); b.w = cvtpk(s1[8 * s + 6], s1[8 * s + 7]);
                    pf[s] = __builtin_bit_cast(bf16x8, a); pf[2 + s] = __builtin_bit_cast(bf16x8, b);
                }
#pragma unroll
                for (int ks = 0; ks < 4; ++ks) {
                    if (ks < 3) ATT_VLD((ks + 1) & 1, ks + 1);
                    __builtin_amdgcn_sched_barrier(0);
#pragma unroll
                    for (int c4 = 0; c4 < 4; ++c4) {
                        const s16x4 lo = vl[ks & 1][c4], hi = vh[ks & 1][c4];
                        const bf16x8 vt = (bf16x8){lo[0], lo[1], lo[2], lo[3], hi[0], hi[1], hi[2], hi[3]};
                        o[c4] = __builtin_amdgcn_mfma_f32_32x32x16_bf16(vt, pf[ks], o[c4], 0, 0, 0);
                    }
                    __builtin_amdgcn_sched_barrier(0);
                }
#undef ATT_VLD
            }
        }
    }
    __syncthreads();
    const float ltot = half_sum(lsum), inv = active ? 1.f / ltot : 0.f;
    ALAS float* xch = (ALAS float*)lds + j * 4096;
    if (c == 1 && active) {
#pragma unroll
        for (int c4 = 0; c4 < 4; ++c4)
#pragma unroll
            for (int i = 0; i < 16; ++i) xch[(c4 * 16 + i) * 64 + lane] = o[c4][i] * inv;
    }
    __syncthreads();
    if (c == 0 && active) {
        float ss = 0.f;
#pragma unroll
        for (int c4 = 0; c4 < 4; ++c4)
#pragma unroll
            for (int i = 0; i < 16; ++i) { const float v = o[c4][i] * inv - lam * xch[(c4 * 16 + i) * 64 + lane]; o[c4][i] = v; ss += v * v; }
        ss = half_sum(ss);
        const float rs = 0.8f / sqrtf(ss * (1.f / 128.f) + EPS);
        bf16_t* op = d.O + (size_t)(32 * j + r32) * DM + 4 * hh;
#pragma unroll
        for (int c4 = 0; c4 < 4; ++c4)
#pragma unroll
            for (int g4 = 0; g4 < 4; ++g4) { const int dv0 = 32 * c4 + 8 * g4;
                const f32x4 g = *(const f32x4*)(subg + dv0 + 4 * hh);
                u32x2 pk; pk.x = cvtpk(o[c4][4 * g4] * rs * g[0], o[c4][4 * g4 + 1] * rs * g[1]); pk.y = cvtpk(o[c4][4 * g4 + 2] * rs * g[2], o[c4][4 * g4 + 3] * rs * g[3]);
                *(u32x2*)(op + dv0) = pk; }
    }
    __syncthreads();
}
#undef ATT_DMA
#undef ALAS
}

#define GAS __attribute__((address_space(1)))
#define LAS __attribute__((address_space(3)))
typedef unsigned short bf16;
typedef unsigned v4u __attribute__((ext_vector_type(4)));
typedef unsigned v2u __attribute__((ext_vector_type(2)));
typedef float f32x4 __attribute__((ext_vector_type(4)));
constexpr int NWAVES = 8, NTHREADS = 512;
constexpr int LDS_BYTES = 147456;
constexpr size_t MiB = 1u << 20;
constexpr size_t WS_MOD = 0;
constexpr size_t WS_QCTR = 1 * MiB + 16384, WS_MAXB = 1 * MiB + 32768;
constexpr size_t WS_BAR = 1 * MiB;
constexpr size_t WS_ROWSS = 1 * MiB + 65536;
constexpr size_t WS_SH2 = 30 * MiB;
constexpr size_t WS_BIAS2 = 26 * MiB;
constexpr size_t CTL_BYTES = 65536 + (size_t)MT * 4;
constexpr int MISC_OFF = 131072 + 320;
constexpr size_t WS_WIN = 2 * MiB, WS_WO = 8 * MiB, WS_W1 = 10 * MiB, WS_W2 = 18 * MiB;
constexpr size_t WS_XN = 32 * MiB;
constexpr size_t WS_HB = 192 * MiB;
constexpr size_t WS_BG = 192 * MiB, WS_CG = 257 * MiB, WS_UG = 322 * MiB, WS_QB = 387 * MiB;
constexpr size_t WS_KB = 452 * MiB, WS_VB = 550 * MiB;
constexpr size_t WS_MIX = 648 * MiB;
constexpr size_t WS_END = 778 * MiB;
static_assert((size_t)MT * HW * 2 <= 65 * MiB && (size_t)KVROWS * HW * 2 <= 98 * MiB && (size_t)MT * DM * 2 <= 130 * MiB && (size_t)MT * FF * 2 <= 520 * MiB, "ws map");

__device__ __forceinline__ unsigned f2bf(float f) { unsigned u = __builtin_bit_cast(unsigned, f); return (u + 0x7fffu + ((u >> 16) & 1u)) >> 16; }
__device__ __forceinline__ unsigned pk2(float lo, float hi) { return f2bf(lo) | (f2bf(hi) << 16); }
__device__ __forceinline__ float bflo(unsigned u) { return __builtin_bit_cast(float, u << 16); }
__device__ __forceinline__ float bfhi(unsigned u) { return __builtin_bit_cast(float, u & 0xffff0000u); }
__device__ __forceinline__ float wave_sum(float v) {
#pragma unroll
    for (int o = 1; o < 64; o <<= 1) v += __shfl_xor(v, o);
    return v;
}
#define LDS_WAIT() asm volatile("s_waitcnt lgkmcnt(0)" ::: "memory")

#define XB_TMO      128
#define XB_XCNT(j)  (256  + 64 * (j))
#define XB_XSUB(j)  (1280 + 64 * (j))
#define XB_XGEN(j)  (2304 + 64 * (j))
#define XB_TOP      3328
#define XB_TOPGEN   3392
#define XCD_BAR_WORDS 3456
#define XB_SPIN_CAP (1u << 18)

__device__ __forceinline__ unsigned xb_ld(unsigned* p)              { return __hip_atomic_load(p, __ATOMIC_RELAXED, __HIP_MEMORY_SCOPE_AGENT); }
__device__ __forceinline__ unsigned xb_add(unsigned* p, unsigned v) { return __hip_atomic_fetch_add(p, v, __ATOMIC_RELAXED, __HIP_MEMORY_SCOPE_AGENT); }
__device__ __forceinline__ unsigned xb_xcc_id() { return (unsigned)__builtin_amdgcn_s_getreg((3 << 11) | 20) & 0xFu; }
#define XB_SPIN(cond, bar) do { unsigned _sp = 0; while (cond) { __builtin_amdgcn_s_sleep(1); \
    if ((++_sp & 255u) == 0u) { if (xb_ld(&(bar)[XB_TMO])) break; if (_sp > XB_SPIN_CAP) { atomicAdd(&(bar)[XB_TMO], 1u); break; } } } } while (0)

struct XcdBarrier {
    unsigned* bar; unsigned x;
    volatile LAS unsigned* st;
};

__device__ __forceinline__ XcdBarrier xcd_barrier_post(unsigned* bar, volatile LAS unsigned* st) {
    XcdBarrier b; b.bar = bar; b.x = xb_xcc_id(); b.st = st;
    if (threadIdx.x == 0) (void)xb_add(&bar[XB_XCNT(b.x)], 1u);
    return b;
}
__device__ __forceinline__ void xcd_barrier_complete(unsigned* bar, unsigned x, unsigned& nloc, unsigned& nx) {
    const unsigned G = gridDim.x * gridDim.y * gridDim.z;
    unsigned sum, cnt, mine, sp = 0u;
    for (;;) {
        sum = 0u; cnt = 0u; mine = 0u;
#pragma unroll
        for (unsigned j = 0; j < 16; ++j) { const unsigned c = xb_ld(&bar[XB_XCNT(j)]); sum += c; cnt += (c > 0u) ? 1u : 0u; mine = (j == x) ? c : mine; }
        if (sum == G) break;
        __builtin_amdgcn_s_sleep(1);
        if ((++sp & 255u) == 0u) { if (xb_ld(&bar[XB_TMO])) break; if (sp > XB_SPIN_CAP) { atomicAdd(&bar[XB_TMO], 1u); break; } }
    }
    nloc = mine > 0u ? mine : 1u; nx = cnt > 0u ? cnt : 1u;
}

__device__ __forceinline__ void xcd_barrier(const XcdBarrier& b) {
    asm volatile("s_waitcnt vmcnt(0)" ::: "memory");
    __syncthreads();
    if (threadIdx.x == 0) {
        unsigned* bar = b.bar;
        __builtin_amdgcn_s_waitcnt(0);
        unsigned nloc = b.st[0], nx = b.st[1];
        if (nloc == 0u) { xcd_barrier_complete(bar, b.x, nloc, nx); b.st[0] = nloc; b.st[1] = nx; }
        const unsigned old = xb_add(&bar[XB_XSUB(b.x)], 1u);
        const unsigned gen = old / nloc;
        if (old + 1u == (gen + 1u) * nloc) {
            __builtin_amdgcn_fence(__ATOMIC_RELEASE, "agent");
            asm volatile("s_waitcnt vmcnt(0)" ::: "memory");
            const unsigned og = xb_add(&bar[XB_TOP], 1u);
            const unsigned tg = og / nx;
            if (og + 1u == (tg + 1u) * nx) xb_add(&bar[XB_TOPGEN], 1u);
            else XB_SPIN(xb_ld(&bar[XB_TOPGEN]) == tg, bar);
            __builtin_amdgcn_fence(__ATOMIC_ACQUIRE, "agent");
            xb_add(&bar[XB_XGEN(b.x)], 1u);
            asm volatile("s_waitcnt vmcnt(0)" ::: "memory");
        } else {
            XB_SPIN(xb_ld(&bar[XB_XGEN(b.x)]) == gen, bar);
            __builtin_amdgcn_fence(__ATOMIC_ACQUIRE, "agent");
            asm volatile("s_waitcnt vmcnt(0)" ::: "memory");
        }
    }
    __syncthreads();
}


struct Args {
    const float *x_p, *x_s, *cache_k, *cache_v, *state_conv, *c_p, *c_s, *norm1_g, *norm2_g, *w_ada, *b_ada, *w_in, *conv_w, *lq1, *lk1, *lq2, *lk2, *subln_g, *w_o, *w_mlp1, *w_mlp2, *final_g;
    float* out; unsigned char* ws; int never; int pad;
};

__device__ __forceinline__ void p0_transpose_item(const float* W, int K, int N, bf16* WT, LAS float* scr, int item, int lane) {
    const int nblk = N / 32, kb = item / nblk, nb = item % nblk, k0 = 64 * kb, n0 = 32 * nb;
#pragma unroll 8
    for (int i = 0; i < 32; ++i) { const int kk = 2 * i + (lane >> 5); scr[kk * 33 + (lane & 31)] = W[(size_t)(k0 + kk) * N + n0 + (lane & 31)]; }
    LDS_WAIT(); asm volatile("" ::: "memory");
    const int c = lane & 7;
#pragma unroll
    for (int j = 0; j < 4; ++j) { const int n = (lane >> 3) + 8 * j; const LAS float* s = scr + (8 * c) * 33 + n;
        v4u o; o.x = pk2(s[0 * 33], s[1 * 33]); o.y = pk2(s[2 * 33], s[3 * 33]); o.z = pk2(s[4 * 33], s[5 * 33]); o.w = pk2(s[6 * 33], s[7 * 33]);
        *(GAS v4u*)(WT + (size_t)(n0 + n) * K + k0 + 8 * c) = o; }
    LDS_WAIT(); asm volatile("" ::: "memory");
}

__device__ __forceinline__ void norm_mod_row(const float* xrow, const float* g, const float* sc, const float* sh, bf16* orow, int lane) {
    const f32x4* xr = (const f32x4*)xrow + lane;
    f32x4 v[4]; float s = 0.f;
#pragma unroll
    for (int j = 0; j < 4; ++j) { v[j] = xr[64 * j]; s += (v[j].x * v[j].x + v[j].y * v[j].y) + (v[j].z * v[j].z + v[j].w * v[j].w); }
    const float rstd = 1.f / sqrtf(wave_sum(s) * (1.f / DM) + EPS);
    unsigned long long* o8 = (unsigned long long*)orow + lane;
#pragma unroll
    for (int j = 0; j < 4; ++j) { const f32x4 gg = ((const f32x4*)g)[lane + 64 * j], cc = ((const f32x4*)sc)[lane + 64 * j], hh = ((const f32x4*)sh)[lane + 64 * j];
        const f32x4 r = v[j] * rstd * gg * (cc + 1.f) + hh;
        o8[64 * j] = (unsigned long long)pk2(r.x, r.y) | ((unsigned long long)pk2(r.z, r.w) << 32); }
}

__global__ void __launch_bounds__(NTHREADS, 2) mega_fwd(Args a) {
    extern __shared__ __attribute__((aligned(16))) unsigned char lds_raw[];
    LAS unsigned char* lds = (LAS unsigned char*)lds_raw;
    cg::grid_group grid = cg::this_grid();
    const int G = gridDim.x; const int bx = blockIdx.x;
    const int vcu = (G % 8 == 0) ? (bx % 8) * (G / 8) + bx / 8 : bx;
    const int NGW = G * NWAVES;
#define PHASE_IDS() int tid_ = threadIdx.x; asm volatile("" : "+v"(tid_)); const int tid = tid_, lane = tid & 63, wave = __builtin_amdgcn_readfirstlane(tid >> 6), gw = vcu * NWAVES + wave; (void)tid; (void)lane; (void)gw
    unsigned char* ws = a.ws;
    float* mod = (float*)(ws + WS_MOD); float* rowss = (float*)(ws + WS_ROWSS); float* bias2 = (float*)(ws + WS_BIAS2); bf16* SH2 = (bf16*)(ws + WS_SH2);
    bf16 *Win_t = (bf16*)(ws + WS_WIN), *Wo_t = (bf16*)(ws + WS_WO), *W1_t = (bf16*)(ws + WS_W1), *W2_t = (bf16*)(ws + WS_W2);
    bf16 *XN = (bf16*)(ws + WS_XN), *HB = (bf16*)(ws + WS_HB), *BG = (bf16*)(ws + WS_BG), *CG = (bf16*)(ws + WS_CG), *UG = (bf16*)(ws + WS_UG), *QB = (bf16*)(ws + WS_QB);
    bf16 *KB = (bf16*)(ws + WS_KB), *VB = (bf16*)(ws + WS_VB), *MIX = (bf16*)(ws + WS_MIX);
    volatile LAS unsigned* MISC = (volatile LAS unsigned*)(lds + MISC_OFF);
    if (threadIdx.x < 32) MISC[threadIdx.x] = 0u;
    unsigned* barw = (unsigned*)(ws + WS_BAR);
    unsigned* qctr = (unsigned*)(ws + WS_QCTR); unsigned* maxbuf = (unsigned*)(ws + WS_MAXB);
    __syncthreads();
    const XcdBarrier bar = xcd_barrier_post(barw, MISC + 8);
#define GRID_SYNC() xcd_barrier(bar)
    if (a.never) grid.sync();

    { PHASE_IDS();
    if (bx < (6 * DM) / 64) {
        const int cb = bx * 64;
        LAS float* sl = (LAS float*)lds + wave * (64 * NMOD);
        float acc[NMOD];
#pragma unroll
        for (int r = 0; r < NMOD; ++r) acc[r] = 0.f;
        for (int half = 0; half < 2; ++half) {
            const int k0 = wave * 128 + half * 64;
            for (int idx = lane; idx < 64 * NMOD; idx += 64) { const int kk = idx & 63, r = idx >> 6;
                const float cv = r < NB_P ? a.c_p[r * DM + k0 + kk] : a.c_s[(r - NB_P) * DM + k0 + kk];
                sl[kk * NMOD + r] = cv / (1.f + __expf(-cv)); }
            LDS_WAIT(); asm volatile("" ::: "memory");
            for (int kk = 0; kk < 64; ++kk) {
                const float wv = a.w_ada[(size_t)(k0 + kk) * (6 * DM) + cb + lane];
                const LAS f32x4* sp = (const LAS f32x4*)(sl + kk * NMOD);
#pragma unroll
                for (int r4 = 0; r4 < NMOD / 4; ++r4) { const f32x4 sv = sp[r4]; acc[4 * r4] += sv.x * wv; acc[4 * r4 + 1] += sv.y * wv; acc[4 * r4 + 2] += sv.z * wv; acc[4 * r4 + 3] += sv.w * wv; }
            }
            LDS_WAIT(); asm volatile("" ::: "memory");
        }
        __syncthreads();
        LAS float* red = (LAS float*)lds;
#pragma unroll
        for (int r = 0; r < NMOD; ++r) red[(wave * NMOD + r) * 64 + lane] = acc[r];
        __syncthreads();
        for (int idx = tid; idx < NMOD * 64; idx += NTHREADS) { const int r = idx >> 6, cl = idx & 63; float s = a.b_ada[cb + cl];
#pragma unroll
            for (int w8 = 0; w8 < 8; ++w8) s += red[(w8 * NMOD + r) * 64 + cl];
            mod[(size_t)r * (6 * DM) + cb + cl] = s; }
        __syncthreads();
    }
    {
        LAS float* scr = (LAS float*)(lds + wave * 16384);
        constexpr int I_IN = (DM / 64) * (INW / 32), I_O = (DM / 64) * (DM / 32), I_1 = (DM / 64) * (FF / 32), I_2 = (FF / 64) * (DM / 32);
        constexpr int NITEMS = I_IN + I_O + I_1 + I_2;
        for (int it = gw; it < NITEMS; it += NGW) {
            int r = it;
            if (r < I_IN) { p0_transpose_item(a.w_in, DM, INW, Win_t, scr, r, lane); continue; } r -= I_IN;
            if (r < I_O) { p0_transpose_item(a.w_o, DM, DM, Wo_t, scr, r, lane); continue; } r -= I_O;
            if (r < I_1) { p0_transpose_item(a.w_mlp1, DM, FF, W1_t, scr, r, lane); continue; } r -= I_1;
            p0_transpose_item(a.w_mlp2, FF, DM, W2_t, scr, r, lane);
        }
        constexpr int NC = NB_S * PAST;
        for (int it = gw; it < 2 * NC; it += NGW) {
            const int which = it >= NC, r = which ? it - NC : it, b = r >> 10, t = r & 1023;
            const float* src = (which ? a.cache_v : a.cache_k) + (size_t)r * HW + lane * 8;
            const f32x4 v0 = *(const f32x4*)src, v1 = *(const f32x4*)(src + 4);
            v4u o; o.x = pk2(v0.x, v0.y); o.y = pk2(v0.z, v0.w); o.z = pk2(v1.x, v1.y); o.w = pk2(v1.z, v1.w);
            *(v4u*)((which ? VB : KB) + (size_t)(MP + b * KVS + t) * HW + lane * 8) = o;
        }
        for (int it = gw; it < 2 * NB_S * 32; it += NGW) {
            const int which = it >= NB_S * 32, r = which ? it - NB_S * 32 : it, b = r >> 5, t = PAST + T_S + (r & 31);
            *(v4u*)((which ? VB : KB) + (size_t)(MP + b * KVS + t) * HW + lane * 8) = (v4u){0u, 0u, 0u, 0u};
        }
    }
    }
    GRID_SYNC();

    { PHASE_IDS();
    if (gw < 256) { unsigned long long* o8 = (unsigned long long*)(SH2 + (size_t)gw * DM) + lane; const f32x4* sp = (const f32x4*)(mod + (size_t)(gw < NMOD ? gw : 0) * (6 * DM) + 3 * DM) + lane;
#pragma unroll
        for (int j = 0; j < 4; ++j) { f32x4 r = sp[64 * j]; if (gw >= NMOD) r = (f32x4){0.f, 0.f, 0.f, 0.f}; o8[64 * j] = (unsigned long long)pk2(r.x, r.y) | ((unsigned long long)pk2(r.z, r.w) << 32); } }
    for (int m = gw; m < MT; m += NGW) {
        const int mrow = m < MP ? (m >> 13) : NB_P + ((m - MP) >> 5);
        const float* xr = m < MP ? a.x_p + (size_t)m * DM : a.x_s + (size_t)(m - MP) * DM;
        const float* mr = mod + (size_t)mrow * (6 * DM);
        norm_mod_row(xr, a.norm1_g, mr + DM, mr, XN + (size_t)m * DM, lane);
    } }
    GRID_SYNC();

    {
        pg8::Gemm g{XN, Win_t, MT, INW, DM}; pg8::StaticOrder S; S.init(MT, INW, G, bx);
        pg8::EpiIn E{BG, CG, UG, QB, KB, VB, a.out, maxbuf};
        pg8::gemm_phase<pg8::EpiIn, pg8::StaticOrder, true, true>(lds, g, S, E);
    }
    GRID_SYNC();

    { PHASE_IDS();
        float lam;
        { float d1 = 0.f, d2 = 0.f; for (int i = 0; i < 64; ++i) { d1 += a.lq1[i] * a.lk1[i]; d2 += a.lq2[i] * a.lk2[i]; } lam = __expf(d1) - __expf(d2) + 0.2f; }
        constexpr int NQI = 256 + (NB_S * 4) / 8;
        int qi = (int)(bar.x & 7u);
        for (int nq = 0; nq < 8;) {
            if (tid == 0) MISC[0] = __hip_atomic_fetch_add(qctr + 64 * qi, 1u, __ATOMIC_RELAXED, __HIP_MEMORY_SCOPE_AGENT);
            __syncthreads();
            const int idx = (int)MISC[0];
            __syncthreads();
            if (idx >= NQI) { qi = (qi + 1) & 7; ++nq; continue; }
            att::UnitDesc d;
            if (idx < 256) {
                const int b = qi, h = 3 - (idx >> 6), qb = 63 - (idx & 63);
                const size_t row0 = (size_t)b * T_P + 128 * qb;
                d.Q = QB + row0 * HW + h * 128; d.K = KB + (size_t)b * T_P * HW + h * 128; d.V = VB + (size_t)b * T_P * HW + h * 128; d.O = MIX + row0 * DM + 512 + h * 128;
                d.q0pos = 128 * qb; d.nvalid = 128; d.kv_len = T_P; d.s_hi = qb; d.slope2 = LOG2E * exp2f(-2.f * (float)(h + 1));
                const unsigned* mq = maxbuf + b * 16 + h * 4; const unsigned* mk = mq + 128;
                const float B0 = sqrtf(__uint_as_float(mq[0]) * __uint_as_float(mk[0])) + sqrtf(__uint_as_float(mq[1]) * __uint_as_float(mk[1]));
                const float B1 = sqrtf(__uint_as_float(mq[2]) * __uint_as_float(mk[2])) + sqrtf(__uint_as_float(mq[3]) * __uint_as_float(mk[3]));
                const float Tn = 2.04f * fmaxf(B0, B1) + 160.f, X = ((float)d.q0pos - 127.f - Tn / d.slope2) * (1.f / 128.f);
                int slo = X > 0.f ? (int)floorf(X) : 0; d.s_lo = slo < qb ? slo : qb;
            } else {
                const int us = qi * ((NB_S * 4) / 8) + idx - 256, b = us >> 2, h = us & 3;
                const size_t row0 = (size_t)MP + b * T_S, kr0 = (size_t)MP + (size_t)b * KVS;
                d.Q = QB + row0 * HW + h * 128; d.K = KB + kr0 * HW + h * 128; d.V = VB + kr0 * HW + h * 128; d.O = MIX + row0 * DM + 512 + h * 128;
                d.q0pos = PAST; d.nvalid = T_S; d.kv_len = PAST + T_S; d.s_hi = (KVS / 64) / 2; d.s_lo = 0; d.slope2 = LOG2E * exp2f(-2.f * (float)(h + 1));
            }
            att::attn_unit(lds, d, lam, a.subln_g);
        }
        const int ch0 = lane * 8;
        float w0[8], w1[8], w2[8];
#pragma unroll
        for (int e = 0; e < 8; ++e) { w0[e] = a.conv_w[ch0 + e]; w1[e] = a.conv_w[HW + ch0 + e]; w2[e] = a.conv_w[2 * HW + ch0 + e]; }
        for (int r = gw; r < MT; r += NGW) {
            const bool smp = r >= MP; const int t = smp ? ((r - MP) & 31) : (r & (T_P - 1)), T = smp ? T_S : T_P, b = smp ? ((r - MP) >> 5) : (r >> 13);
            float uc[3][8];
#pragma unroll
            for (int k = 0; k < 3; ++k) {
                if (t - k >= 0) { const v4u cv = *(const v4u*)(CG + (size_t)(r - k) * HW + ch0), uv = *(const v4u*)(UG + (size_t)(r - k) * HW + ch0);
                    uc[k][0] = bflo(cv.x) * bflo(uv.x); uc[k][1] = bfhi(cv.x) * bfhi(uv.x); uc[k][2] = bflo(cv.y) * bflo(uv.y); uc[k][3] = bfhi(cv.y) * bfhi(uv.y);
                    uc[k][4] = bflo(cv.z) * bflo(uv.z); uc[k][5] = bfhi(cv.z) * bfhi(uv.z); uc[k][6] = bflo(cv.w) * bflo(uv.w); uc[k][7] = bfhi(cv.w) * bfhi(uv.w);
                } else if (smp) { const float* sp = a.state_conv + ((size_t)b * 2 + (2 + t - k)) * HW + ch0; const f32x4 s0 = *(const f32x4*)sp, s1 = *(const f32x4*)(sp + 4);
                    uc[k][0] = s0.x; uc[k][1] = s0.y; uc[k][2] = s0.z; uc[k][3] = s0.w; uc[k][4] = s1.x; uc[k][5] = s1.y; uc[k][6] = s1.z; uc[k][7] = s1.w;
                } else {
#pragma unroll
                    for (int e = 0; e < 8; ++e) uc[k][e] = 0.f; }
            }
            const v4u bv = *(const v4u*)(BG + (size_t)r * HW + ch0);
            float bb[8] = {bflo(bv.x), bfhi(bv.x), bflo(bv.y), bfhi(bv.y), bflo(bv.z), bfhi(bv.z), bflo(bv.w), bfhi(bv.w)};
            float y[8];
#pragma unroll
            for (int e = 0; e < 8; ++e) y[e] = bb[e] * (w0[e] * uc[2][e] + w1[e] * uc[1][e] + w2[e] * uc[0][e]);
            v4u o; o.x = pk2(y[0], y[1]); o.y = pk2(y[2], y[3]); o.z = pk2(y[4], y[5]); o.w = pk2(y[6], y[7]);
            *(v4u*)(MIX + (size_t)r * DM + ch0) = o;
            if (t >= T - 2) { float* cp = a.out + (smp ? O_CS : O_CP) + ((size_t)b * 2 + (t - (T - 2))) * HW + ch0;
                *(f32x4*)cp = (f32x4){uc[0][0], uc[0][1], uc[0][2], uc[0][3]}; *(f32x4*)(cp + 4) = (f32x4){uc[0][4], uc[0][5], uc[0][6], uc[0][7]}; }
        }
    }
    GRID_SYNC();

    {
        pg8::Gemm g{MIX, Wo_t, MT, DM, DM}; pg8::StaticOrder S; S.init(MT, DM, G, bx);
        pg8::EpiResGate2 E{a.x_p, a.x_s, a.out, mod + 2 * DM, mod + 4 * DM, a.norm2_g, XN, rowss};
        pg8::gemm_phase<pg8::EpiResGate2, pg8::StaticOrder, true, true>(lds, g, S, E);
        const int c2 = G >= 48 ? bx - 16 : bx;
        if (c2 >= 0 && c2 < 16) { pg8::Gemm gb{SH2, W1_t, 256, FF, DM, 0}; pg8::SplitOrder Sb{1, FF / 256, 1, 1, 16, c2};
            pg8::EpiPartial Eb{bias2, 1, 256, FF};
            pg8::gemm_phase<pg8::EpiPartial, pg8::SplitOrder, true, true>(lds, gb, Sb, Eb); }
    }
    GRID_SYNC();

    {
        pg8::Gemm g{XN, W1_t, MT, FF, DM}; pg8::StaticOrder S; S.init(MT, FF, G, bx);
        pg8::EpiRelu2N E{HB, FF, rowss, bias2};
        pg8::gemm_phase<pg8::EpiRelu2N, pg8::StaticOrder, true, true>(lds, g, S, E);
    }
    GRID_SYNC();

    {
        pg8::Gemm g{HB, W2_t, MP, DM, FF}; pg8::StaticOrder S; S.init(MP, DM, G, bx);
        pg8::EpiResGate E{a.out, a.out + (size_t)MP * DM, a.out, mod + 5 * DM};
        pg8::gemm_phase<pg8::EpiResGate, pg8::StaticOrder, true, true>(lds, g, S, E);
        pg8::Gemm g2{HB + (size_t)MP * FF, W2_t, MS, DM, FF, 256}; pg8::SplitOrder S2{MS / 256, DM / 256, FF / 256, 256, G, bx};
        pg8::EpiPartial E2{(float*)(ws + WS_XN), 256, MS, DM};
        pg8::gemm_phase<pg8::EpiPartial, pg8::SplitOrder, true, true>(lds, g2, S2, E2);
    }
    GRID_SYNC();

    { PHASE_IDS();
    for (int m = gw; m < MT; m += NGW) {
        f32x4* xr = (f32x4*)(a.out + (size_t)m * DM) + lane;
        f32x4 v[4]; float s = 0.f;
#pragma unroll
        for (int j = 0; j < 4; ++j) v[j] = xr[64 * j];
        if (m >= MP) {
            const f32x4* pp = (const f32x4*)(ws + WS_XN) + (size_t)(m - MP) * (DM / 4) + lane; const f32x4* gp = (const f32x4*)(mod + (size_t)(NB_P + ((m - MP) >> 5)) * (6 * DM) + 5 * DM) + lane;
#pragma unroll
            for (int j = 0; j < 4; ++j) { f32x4 t = pp[64 * j];
                for (int s2 = 1; s2 < FF / 256; ++s2) t += pp[(size_t)s2 * MS * (DM / 4) + 64 * j];
                v[j] += gp[64 * j] * t; }
        }
#pragma unroll
        for (int j = 0; j < 4; ++j) s += (v[j].x * v[j].x + v[j].y * v[j].y) + (v[j].z * v[j].z + v[j].w * v[j].w);
        const float rstd = 1.f / sqrtf(wave_sum(s) * (1.f / DM) + EPS);
#pragma unroll
        for (int j = 0; j < 4; ++j) xr[64 * j] = v[j] * rstd * ((const f32x4*)a.final_g)[lane + 64 * j];
    } }
}

extern "C" void kernel_launch(void* const* d_in, const int* in_sizes, int n_in, void* d_out, int out_size, void* d_ws, size_t ws_size, hipStream_t stream) {
    static int grid = 0;
    if (grid == 0) {
        if (n_in != 22 || in_sizes[0] != MP * DM || (size_t)out_size != O_END || ws_size < WS_END) {
            fprintf(stderr, "kernel_launch: unexpected shapes: n_in %d in0 %d out %d ws %zu (need %zu)\n", n_in, n_in > 0 ? in_sizes[0] : -1, out_size, ws_size, (size_t)WS_END); grid = -1; return; }
        int dev = 0, cus = 0, per_cu = 0;
        (void)hipGetDevice(&dev); (void)hipDeviceGetAttribute(&cus, hipDeviceAttributeMultiprocessorCount, dev);
        if (hipFuncSetAttribute((const void*)mega_fwd, hipFuncAttributeMaxDynamicSharedMemorySize, LDS_BYTES) != hipSuccess) { fprintf(stderr, "kernel_launch: hipFuncSetAttribute failed\n"); grid = -1; return; }
        if (hipOccupancyMaxActiveBlocksPerMultiprocessor(&per_cu, (const void*)mega_fwd, NTHREADS, LDS_BYTES) != hipSuccess || per_cu < 1) { fprintf(stderr, "kernel_launch: occupancy query says %d\n", per_cu); per_cu = 1; }
        (void)hipGetLastError();
        grid = cus * per_cu;
        fprintf(stderr, "kernel_launch: grid %d (cus %d x %d)\n", grid, cus, per_cu);
    }
    if (grid < 0) return;
    Args a{};
    const float** p = (const float**)&a;
    for (int i = 0; i < 22; ++i) p[i] = (const float*)d_in[i];
    a.out = (float*)d_out; a.ws = (unsigned char*)d_ws;
    if (hipMemsetAsync((char*)d_ws + WS_BAR, 0, CTL_BYTES, stream) != hipSuccess) { fprintf(stderr, "kernel_launch: hipMemsetAsync failed\n"); return; }
    void* args[] = {&a};
    hipError_t e = hipLaunchCooperativeKernel((const void*)mega_fwd, dim3(grid), dim3(NTHREADS), args, LDS_BYTES, stream);
    if (e != hipSuccess) fprintf(stderr, "kernel_launch: cooperative launch failed: %s (grid %d)\n", hipGetErrorString(e), grid);
}
```

```cpp
#include <hip/hip_runtime.h>
#include <hip/hip_cooperative_groups.h>
#include <cstdio>
#include <cstdint>
namespace cg = cooperative_groups;

constexpr int DM = 1024, NB_P = 8, T_P = 8192, NB_S = 32, T_S = 32, PAST = 1024;
constexpr int MP = NB_P * T_P, MS = NB_S * T_S, MT = MP + MS;
constexpr int INW = 3072, FF = 4096, HW = 512;
constexpr int KVS = 1088;
constexpr int KVROWS = MP + NB_S * KVS;
constexpr int NMOD = NB_P + NB_S;
constexpr float EPS = 1e-5f;
constexpr float LOG2E = 1.4426950408889634f;
constexpr float QSCALE = 0.125f * LOG2E;
constexpr size_t O_YP = 0, O_YS = (size_t)MP * DM, O_KP = O_YS + (size_t)MS * DM, O_VP = O_KP + (size_t)MP * HW, O_CP = O_VP + (size_t)MP * HW,
                 O_KS = O_CP + (size_t)NB_P * 2 * HW, O_VS = O_KS + (size_t)MS * HW, O_CS = O_VS + (size_t)MS * HW, O_END = O_CS + (size_t)NB_S * 2 * HW;

namespace pg8 {
#define PG8_LAS __attribute__((address_space(3)))
typedef unsigned short bf16_t;
typedef short bf16x8 __attribute__((ext_vector_type(8)));
typedef float f32x4 __attribute__((ext_vector_type(4)));
typedef unsigned u32x4 __attribute__((ext_vector_type(4)));
constexpr int BM = 256, BK = 64, HALF = 128, HTB = HALF * BK * 2  , STAGE_BYTES = 8 * HTB, NXCD = 8, WGM = 8;

__host__ __device__ __forceinline__ int lds_byte(int r, int c) { const int st = (r >> 4) * 2 + (c >> 5), rr = r & 15, cc = c & 31, ob = rr * 64 + cc * 2; return st * 1024 + (ob ^ (((ob >> 9) & 1) << 5)); }
__host__ __device__ __forceinline__ void stage_rc(int b, int& R, int& C) { const int st = b / 1024, sb = b % 1024, swz = sb ^ (((sb >> 9) & 1) << 5); R = (st >> 1) * 16 + swz / 64; C = (st & 1) * 32 + (swz % 64) / 2; }
__host__ __device__ __forceinline__ int perm32(int rho) { const int n = rho >> 4, i = rho & 15; return 8 * (i >> 2) + 4 * n + (i & 3); }

struct Unit { int pm, pn, k0; };
struct Gemm { const bf16_t* A; const bf16_t* Bt; int M, N, K, Kext; };

struct StaticOrder {
    int nM, nN, nwg, G, c;
    __host__ __device__ void init(int M, int N, int G_, int c_) { nM = M / BM; nN = N / BM; nwg = nM * nN; G = G_; c = c_; }
    __host__ __device__ bool next(int i, Unit& u) const {
        const long L = (long)i * G + c; if (L >= nwg) return false;
        int wgid = (int)L; { const int q = nwg / NXCD, r = nwg % NXCD, xcd = wgid % NXCD, off = wgid / NXCD; wgid = (xcd < r ? xcd * (q + 1) : r * (q + 1) + (xcd - r) * q) + off; }
        const int nig = WGM * nN, gid = wgid / nig, fm = gid * WGM, gsz = (nM - fm) < WGM ? (nM - fm) : WGM;
        u.pm = fm + ((wgid % nig) % gsz); u.pn = (wgid % nig) / gsz; u.k0 = 0; return true;
    }
    __device__ __forceinline__ void a_ready(const Unit&) const {}
    __device__ __forceinline__ void done(const Unit&) const {}
};

struct SplitOrder {
    int nM, nN, nS, ksz, G, c;
    __host__ __device__ bool next(int i, Unit& u) const { const int L = i * G + c; if (L >= nM * nN * nS) return false; u.pm = L % nM; u.pn = (L / nM) % nN; u.k0 = (L / (nM * nN)) * ksz; return true; }
    __device__ __forceinline__ void a_ready(const Unit&) const {}
    __device__ __forceinline__ void done(const Unit&) const {}
};

__device__ __forceinline__ unsigned cvt_pk_bf16(float lo, float hi) { unsigned r; asm volatile("v_cvt_pk_bf16_f32 %0, %1, %2" : "=v"(r) : "v"(lo), "v"(hi)); return r; }
__device__ __forceinline__ u32x4 pack8(f32x4 v0, f32x4 v1) { u32x4 w; w.x = cvt_pk_bf16(v0[0], v0[1]); w.y = cvt_pk_bf16(v0[2], v0[3]); w.z = cvt_pk_bf16(v1[0], v1[1]); w.w = cvt_pk_bf16(v1[2], v1[3]); return w; }

__device__ __forceinline__ float fq_sum(float v) {
    auto a = __builtin_amdgcn_permlane16_swap(__float_as_uint(v), __float_as_uint(v), false, false); v = __uint_as_float(a[0]) + __uint_as_float(a[1]);
    auto b = __builtin_amdgcn_permlane32_swap(__float_as_uint(v), __float_as_uint(v), false, false); return __uint_as_float(b[0]) + __uint_as_float(b[1]); }
struct EpiIn {
    static constexpr bool PERM = true, AFTER_DRAIN = false;
    bf16_t *BG, *CG, *UG, *QB, *KB, *VB; float* out; unsigned* maxbuf;
    __device__ __forceinline__ void operator()(const f32x4 (&acc)[2][2][4][2], const Unit& u, int wr, int wc, int fr, int fq) const {
        const int seg = u.pn >> 1, col0 = (u.pn & 1) * 256 + wc * 32 + 8 * fq, row0 = u.pm * BM + wr * 64 + fr;
        const bool smp = u.pm >= (MP / BM);
        if (!smp && (seg == 3 || seg == 4)) {
            const float sc2 = seg == 3 ? QSCALE * QSCALE : 1.f; float mx[2] = {0.f, 0.f};
#pragma unroll
            for (int ai = 0; ai < 2; ++ai)
#pragma unroll
                for (int m = 0; m < 4; ++m)
#pragma unroll
                    for (int bj = 0; bj < 2; ++bj) { const f32x4 v0 = acc[ai][bj][m][0], v1 = acc[ai][bj][m][1];
                        float ss = (v0[0] * v0[0] + v0[1] * v0[1]) + (v0[2] * v0[2] + v0[3] * v0[3]) + (v1[0] * v1[0] + v1[1] * v1[1]) + (v1[2] * v1[2] + v1[3] * v1[3]);
                        ss = fq_sum(ss); mx[bj] = fmaxf(mx[bj], ss * sc2); }
#pragma unroll
            for (int bj = 0; bj < 2; ++bj)
                if (fq == 0) atomicMax(maxbuf + (seg == 4 ? 128 : 0) + (u.pm >> 5) * 16 + (u.pn & 1) * 8 + bj * 4 + wc, __float_as_uint(mx[bj]));
        }
        if (seg < 4) {
            bf16_t* base = seg == 0 ? BG : seg == 1 ? CG : seg == 2 ? UG : QB; const float sc = seg == 3 ? QSCALE : 1.f;
#pragma unroll
            for (int ai = 0; ai < 2; ++ai)
#pragma unroll
                for (int m = 0; m < 4; ++m) { bf16_t* rowp = base + (size_t)(row0 + ai * HALF + m * 16) * HW + col0;
#pragma unroll
                    for (int bj = 0; bj < 2; ++bj) *(u32x4*)(rowp + bj * HALF) = pack8(acc[ai][bj][m][0] * sc, acc[ai][bj][m][1] * sc); }
        } else {
            bf16_t* kvb = seg == 4 ? KB : VB;
            float* ob = out + (smp ? (seg == 4 ? O_KS : O_VS) : (seg == 4 ? O_KP : O_VP));
#pragma unroll
            for (int ai = 0; ai < 2; ++ai)
#pragma unroll
                for (int m = 0; m < 4; ++m) { const int row = row0 + ai * HALF + m * 16; const int rs = row - MP;
                    const size_t orow = smp ? (size_t)rs : (size_t)row;
                    const size_t kvrow = smp ? (size_t)(MP + (rs >> 5) * KVS + PAST + (rs & 31)) : (size_t)row;
                    float* op = ob + orow * HW + col0; bf16_t* kp = kvb + kvrow * HW + col0;
#pragma unroll
                    for (int bj = 0; bj < 2; ++bj) { const f32x4 v0 = acc[ai][bj][m][0], v1 = acc[ai][bj][m][1];
                        __builtin_nontemporal_store(v0, (f32x4*)(op + bj * HALF)); __builtin_nontemporal_store(v1, (f32x4*)(op + bj * HALF + 4)); *(u32x4*)(kp + bj * HALF) = pack8(v0, v1); } }
        }
    }
};
struct EpiResGate {
    static constexpr bool PERM = true, AFTER_DRAIN = false;
    const float* res_p; const float* res_s; float* out; const float* gate;
    __device__ __forceinline__ void operator()(const f32x4 (&acc)[2][2][4][2], const Unit& u, int wr, int wc, int fr, int fq) const {
        const int col0 = u.pn * BM + wc * 32 + 8 * fq, row0 = u.pm * BM + wr * 64 + fr;
#pragma unroll
        for (int ai = 0; ai < 2; ++ai)
#pragma unroll
            for (int m = 0; m < 4; ++m) { const int row = row0 + ai * HALF + m * 16;
                const int mrow = row < MP ? (row >> 13) : NB_P + ((row - MP) >> 5);
                const float* rp = (row < MP ? res_p + (size_t)row * DM : res_s + (size_t)(row - MP) * DM) + col0;
                const float* gp = gate + (size_t)mrow * (6 * DM) + col0; float* op = out + (size_t)row * DM + col0;
#pragma unroll
                for (int bj = 0; bj < 2; ++bj) {
                    const f32x4 g0 = *(const f32x4*)(gp + bj * HALF), g1 = *(const f32x4*)(gp + bj * HALF + 4);
                    const f32x4 x0 = *(const f32x4*)(rp + bj * HALF), x1 = *(const f32x4*)(rp + bj * HALF + 4);
                    *(f32x4*)(op + bj * HALF) = x0 + g0 * acc[ai][bj][m][0]; *(f32x4*)(op + bj * HALF + 4) = x1 + g1 * acc[ai][bj][m][1]; }
                if (m & 1) asm volatile("" ::: "memory"); }
    }
};
struct EpiRelu2 {
    static constexpr bool PERM = true, AFTER_DRAIN = false;
    bf16_t* O; int ldc;
    __device__ __forceinline__ void operator()(const f32x4 (&acc)[2][2][4][2], const Unit& u, int wr, int wc, int fr, int fq) const {
        const int col0 = u.pn * BM + wc * 32 + 8 * fq, row0 = u.pm * BM + wr * 64 + fr;
#pragma unroll
        for (int ai = 0; ai < 2; ++ai)
#pragma unroll
            for (int m = 0; m < 4; ++m) { bf16_t* rowp = O + (size_t)(row0 + ai * HALF + m * 16) * ldc + col0;
#pragma unroll
                for (int bj = 0; bj < 2; ++bj) { f32x4 v0 = acc[ai][bj][m][0], v1 = acc[ai][bj][m][1];
#pragma unroll
                    for (int e = 0; e < 4; ++e) { const float a = fmaxf(v0[e], 0.f), b = fmaxf(v1[e], 0.f); v0[e] = a * a; v1[e] = b * b; }
                    *(u32x4*)(rowp + bj * HALF) = pack8(v0, v1); } }
    }
};

struct EpiResGate2 {
    static constexpr bool PERM = true, AFTER_DRAIN = false;
    const float* res_p; const float* res_s; float* out; const float* gate; const float* sc2; const float* n2g; bf16_t* XN; float* rowss;
    __device__ __forceinline__ void operator()(const f32x4 (&acc)[2][2][4][2], const Unit& u, int wr, int wc, int fr, int fq) const {
        const int col0 = u.pn * BM + wc * 32 + 8 * fq, row0 = u.pm * BM + wr * 64 + fr;
#pragma unroll
        for (int ai = 0; ai < 2; ++ai)
#pragma unroll
            for (int m = 0; m < 4; ++m) { const int row = row0 + ai * HALF + m * 16;
                const int mrow = row < MP ? (row >> 13) : NB_P + ((row - MP) >> 5);
                const float* rp = (row < MP ? res_p + (size_t)row * DM : res_s + (size_t)(row - MP) * DM) + col0;
                const float* gp = gate + (size_t)mrow * (6 * DM) + col0; const float* cp = sc2 + (size_t)mrow * (6 * DM) + col0; float* op = out + (size_t)row * DM + col0;
                bf16_t* xp = XN + (size_t)row * DM + col0; float ss = 0.f;
#pragma unroll
                for (int bj = 0; bj < 2; ++bj) {
                    const f32x4 g0 = *(const f32x4*)(gp + bj * HALF), g1 = *(const f32x4*)(gp + bj * HALF + 4);
                    const f32x4 x0 = *(const f32x4*)(rp + bj * HALF), x1 = *(const f32x4*)(rp + bj * HALF + 4);
                    const f32x4 y0 = x0 + g0 * acc[ai][bj][m][0], y1 = x1 + g1 * acc[ai][bj][m][1];
                    *(f32x4*)(op + bj * HALF) = y0; *(f32x4*)(op + bj * HALF + 4) = y1;
                    ss += (y0[0] * y0[0] + y0[1] * y0[1]) + (y0[2] * y0[2] + y0[3] * y0[3]) + (y1[0] * y1[0] + y1[1] * y1[1]) + (y1[2] * y1[2] + y1[3] * y1[3]);
                    const f32x4 n0 = *(const f32x4*)(n2g + col0 + bj * HALF), n1 = *(const f32x4*)(n2g + col0 + bj * HALF + 4);
                    const f32x4 c0 = *(const f32x4*)(cp + bj * HALF), c1 = *(const f32x4*)(cp + bj * HALF + 4);
                    *(u32x4*)(xp + bj * HALF) = pack8(y0 * n0 * (c0 + 1.f), y1 * n1 * (c1 + 1.f)); }
                ss = fq_sum(ss);
                if (fq == 0) unsafeAtomicAdd(rowss + row, ss);
                asm volatile("" ::: "memory"); }
    }
};
struct EpiRelu2N {
    static constexpr bool PERM = true, AFTER_DRAIN = false;
    bf16_t* O; int ldc; const float* rowss; const float* bias2;
    __device__ __forceinline__ void operator()(const f32x4 (&acc)[2][2][4][2], const Unit& u, int wr, int wc, int fr, int fq) const {
        const int col0 = u.pn * BM + wc * 32 + 8 * fq, row0 = u.pm * BM + wr * 64 + fr;
#pragma unroll
        for (int ai = 0; ai < 2; ++ai)
#pragma unroll
            for (int m = 0; m < 4; ++m) { const int row = row0 + ai * HALF + m * 16; const int mrow = row < MP ? (row >> 13) : NB_P + ((row - MP) >> 5);
                const float rstd = 1.f / sqrtf(rowss[row] * (1.f / DM) + EPS);
                const float* bp = bias2 + (size_t)mrow * FF + col0; bf16_t* rowp = O + (size_t)row * ldc + col0;
#pragma unroll
                for (int bj = 0; bj < 2; ++bj) { f32x4 v0 = acc[ai][bj][m][0] * rstd + *(const f32x4*)(bp + bj * HALF), v1 = acc[ai][bj][m][1] * rstd + *(const f32x4*)(bp + bj * HALF + 4);
#pragma unroll
                    for (int e = 0; e < 4; ++e) { const float a = fmaxf(v0[e], 0.f), b = fmaxf(v1[e], 0.f); v0[e] = a * a; v1[e] = b * b; }
                    *(u32x4*)(rowp + bj * HALF) = pack8(v0, v1); } }
    }
};
struct EpiPartial {
    static constexpr bool PERM = true, AFTER_DRAIN = false;
    float* part; int ksz, nrows, ld;
    __device__ __forceinline__ void operator()(const f32x4 (&acc)[2][2][4][2], const Unit& u, int wr, int wc, int fr, int fq) const {
        const int col0 = u.pn * BM + wc * 32 + 8 * fq, row0 = u.pm * BM + wr * 64 + fr;
        float* pb = part + (size_t)(u.k0 / ksz) * nrows * ld;
#pragma unroll
        for (int ai = 0; ai < 2; ++ai)
#pragma unroll
            for (int m = 0; m < 4; ++m) { float* op = pb + (size_t)(row0 + ai * HALF + m * 16) * ld + col0;
#pragma unroll
                for (int bj = 0; bj < 2; ++bj) { *(f32x4*)(op + bj * HALF) = acc[ai][bj][m][0]; *(f32x4*)(op + bj * HALF + 4) = acc[ai][bj][m][1]; } }
    }
};

template <class Epi, class Sched, bool ALIGN_EPI = false, bool SP2 = false>
__device__ __forceinline__ void gemm_phase(PG8_LAS unsigned char* lds, const Gemm g, const Sched& S, const Epi& E) {
    int tid = threadIdx.x; asm volatile("" : "+v"(tid));
    const int wid = __builtin_amdgcn_readfirstlane(tid >> 6), lane = tid & 63, wr = wid >> 2, wc = wid & 3, fr = lane & 15, fq = lane >> 4;
    const int K = g.K, nt = (g.Kext ? g.Kext : K) / BK;
    unsigned voffA[2], voffB[2];
#pragma unroll
    for (int i = 0; i < 2; ++i) { int R, C; stage_rc(tid * 16 + i * 8192, R, C); const int Rb = Epi::PERM ? ((R & ~31) + perm32(R & 31)) : R;
        voffA[i] = (unsigned)(R * K + C) * 2u; voffB[i] = (unsigned)(Rb * K + C) * 2u; }
    const size_t kstep = (size_t)(BK * 2);
    const size_t hstep = (size_t)HALF * K * 2;
    const size_t tstep = 2 * hstep;
    const unsigned ldsw = (unsigned)wid * 1024u;
    const int aoff = lds_byte(wr * 64 + fr, fq * 8), boff = lds_byte(wc * 32 + fr, fq * 8);
#define PG8_SA(b, h) (((b) * 2 + (h)) * HTB)
#define PG8_SB(b, h) ((4 + (b) * 2 + (h)) * HTB)
#define PG8_STAGE(bufoff, gbase, voff) do { _Pragma("unroll") for (int _i = 0; _i < 2; ++_i) \
        __builtin_amdgcn_global_load_lds((const unsigned*)((const char*)(gbase) + (voff)[_i]), (PG8_LAS unsigned*)(lds + (bufoff) + ldsw + _i * 8192), 16, 0, 0); } while (0)
#define PG8_LDA(dst, b, h) do { _Pragma("unroll") for (int m = 0; m < 4; ++m) _Pragma("unroll") for (int k = 0; k < 2; ++k) dst[m][k] = *(const PG8_LAS bf16x8*)(lds + PG8_SA(b, h) + aoff + m * 2048 + k * 1024); } while (0)
#define PG8_LDB(dst, b, h) do { _Pragma("unroll") for (int n = 0; n < 2; ++n) _Pragma("unroll") for (int k = 0; k < 2; ++k) dst[n][k] = *(const PG8_LAS bf16x8*)(lds + PG8_SB(b, h) + boff + n * 2048 + k * 1024); } while (0)
#define PG8_MMA(ai, bj, At, Bt) do { __builtin_amdgcn_s_setprio(1); _Pragma("unroll") for (int m = 0; m < 4; ++m) _Pragma("unroll") for (int n = 0; n < 2; ++n) _Pragma("unroll") for (int k = 0; k < 2; ++k) \
        acc[ai][bj][m][n] = __builtin_amdgcn_mfma_f32_16x16x32_bf16(Bt[n][k], At[m][k], acc[ai][bj][m][n], 0, 0, 0); __builtin_amdgcn_s_setprio(0); } while (0)
#define PG8_WAIT_V(n) asm volatile("s_waitcnt vmcnt(" #n ")" ::: "memory")
#define PG8_WAIT_L(n) asm volatile("s_waitcnt lgkmcnt(" #n ")" ::: "memory")
#define PG8_BAR __builtin_amdgcn_s_barrier()
#define PG8_SCHED __builtin_amdgcn_sched_barrier(0)
    Unit cur, nxt; int ui = 0;
    if (!S.next(0, cur)) return;
    f32x4 acc[2][2][4][2];
#pragma unroll
    for (int a = 0; a < 2; ++a)
#pragma unroll
        for (int b = 0; b < 2; ++b)
#pragma unroll
            for (int m = 0; m < 4; ++m)
#pragma unroll
                for (int n = 0; n < 2; ++n) acc[a][b][m][n] = (f32x4){0.f, 0.f, 0.f, 0.f};
    bf16x8 At[4][2], B0[2][2], B1[2][2];
    const char* cA = (const char*)g.A + (size_t)cur.pm * tstep + (size_t)cur.k0 * 2; const char* cB = (const char*)g.Bt + (size_t)cur.pn * tstep + (size_t)cur.k0 * 2;
    S.a_ready(cur);
    if constexpr (SP2) {
        PG8_STAGE(PG8_SB(0, 0), cB, voffB); PG8_STAGE(PG8_SB(0, 1), cB + hstep, voffB); PG8_STAGE(PG8_SA(0, 0), cA, voffA); PG8_STAGE(PG8_SA(0, 1), cA + hstep, voffA);
        if (wr == 1) PG8_BAR;
        PG8_WAIT_V(2); PG8_BAR;
        PG8_STAGE(PG8_SB(1, 0), cB + kstep, voffB); PG8_STAGE(PG8_SA(1, 0), cA + kstep, voffA); PG8_STAGE(PG8_SB(1, 1), cB + hstep + kstep, voffB);
        PG8_WAIT_V(6); PG8_BAR;
    } else {
        PG8_STAGE(PG8_SB(0, 0), cB, voffB); PG8_STAGE(PG8_SA(0, 0), cA, voffA); PG8_STAGE(PG8_SB(0, 1), cB + hstep, voffB); PG8_STAGE(PG8_SA(0, 1), cA + hstep, voffA);
        if (wr == 1) PG8_BAR;
        PG8_WAIT_V(4); PG8_BAR;
        PG8_STAGE(PG8_SB(1, 0), cB + kstep, voffB); PG8_STAGE(PG8_SA(1, 0), cA + kstep, voffA); PG8_STAGE(PG8_SB(1, 1), cB + hstep + kstep, voffB);
        PG8_WAIT_V(6); PG8_BAR;
    }
    for (;;) {
        const bool has_next = S.next(ui + 1, nxt);
        const char* nA = has_next ? (const char*)g.A + (size_t)nxt.pm * tstep + (size_t)nxt.k0 * 2 : cA; const char* nB = has_next ? (const char*)g.Bt + (size_t)nxt.pn * tstep + (size_t)nxt.k0 * 2 : cB;
        for (int t = 0; t < nt; t += 2) {
            const bool last = (t == nt - 2);
            const char* a1 = cA + (size_t)(t + 1) * kstep;
            const char* a2 = last ? nA : cA + (size_t)(t + 2) * kstep; const char* b2 = last ? nB : cB + (size_t)(t + 2) * kstep;
            const char* a3 = a2 + kstep; const char* b3 = b2 + kstep;
            if (last && has_next) S.a_ready(nxt);
            if constexpr (SP2) {
            PG8_LDB(B0, 0, 0); PG8_LDB(B1, 0, 1); PG8_SCHED; PG8_LDA(At, 0, 0); PG8_STAGE(PG8_SA(1, 1), a1 + hstep, voffA);
            PG8_WAIT_V(8); PG8_WAIT_L(0); PG8_BAR; PG8_MMA(0, 0, At, B0); PG8_MMA(0, 1, At, B1); PG8_BAR; PG8_SCHED;
            PG8_LDA(At, 0, 1); PG8_STAGE(PG8_SB(0, 0), b2, voffB); PG8_STAGE(PG8_SB(0, 1), b2 + hstep, voffB); PG8_STAGE(PG8_SA(0, 0), a2, voffA);
            PG8_WAIT_V(8); PG8_WAIT_L(0); PG8_BAR; PG8_MMA(1, 0, At, B0); PG8_MMA(1, 1, At, B1); PG8_BAR; PG8_SCHED;
            PG8_LDB(B0, 1, 0); PG8_LDB(B1, 1, 1); PG8_SCHED; PG8_LDA(At, 1, 0); PG8_STAGE(PG8_SA(0, 1), a2 + hstep, voffA);
            PG8_WAIT_V(8); PG8_WAIT_L(0); PG8_BAR; PG8_MMA(0, 0, At, B0); PG8_MMA(0, 1, At, B1); PG8_BAR; PG8_SCHED;
            PG8_LDA(At, 1, 1); PG8_STAGE(PG8_SB(1, 0), b3, voffB); PG8_STAGE(PG8_SB(1, 1), b3 + hstep, voffB); PG8_STAGE(PG8_SA(1, 0), a3, voffA);
            PG8_WAIT_V(8); PG8_WAIT_L(0); PG8_BAR; PG8_MMA(1, 0, At, B0); PG8_MMA(1, 1, At, B1); PG8_BAR; PG8_SCHED;
            } else {
            PG8_LDB(B0, 0, 0); PG8_SCHED; PG8_LDA(At, 0, 0); PG8_STAGE(PG8_SA(1, 1), a1 + hstep, voffA);
            PG8_WAIT_L(8); PG8_BAR; PG8_WAIT_L(0); PG8_MMA(0, 0, At, B0); PG8_BAR; PG8_SCHED;
            PG8_LDB(B1, 0, 1); PG8_STAGE(PG8_SB(0, 0), b2, voffB);
            PG8_BAR; PG8_WAIT_L(0); PG8_MMA(0, 1, At, B1); PG8_BAR;
            PG8_LDA(At, 0, 1); PG8_STAGE(PG8_SA(0, 0), a2, voffA);
            PG8_BAR; PG8_WAIT_L(0); PG8_MMA(1, 0, At, B0); PG8_BAR; PG8_SCHED;
            PG8_STAGE(PG8_SB(0, 1), b2 + hstep, voffB);
            PG8_WAIT_V(6); PG8_BAR; PG8_MMA(1, 1, At, B1); PG8_BAR;
            PG8_LDB(B0, 1, 0); PG8_SCHED; PG8_LDA(At, 1, 0); PG8_STAGE(PG8_SA(0, 1), a2 + hstep, voffA);
            PG8_WAIT_L(8); PG8_BAR; PG8_WAIT_L(0); PG8_MMA(0, 0, At, B0); PG8_BAR; PG8_SCHED;
            PG8_LDB(B1, 1, 1); PG8_STAGE(PG8_SB(1, 0), b3, voffB);
            PG8_BAR; PG8_WAIT_L(0); PG8_MMA(0, 1, At, B1); PG8_BAR;
            PG8_LDA(At, 1, 1); PG8_STAGE(PG8_SA(1, 0), a3, voffA);
            PG8_BAR; PG8_WAIT_L(0); PG8_MMA(1, 0, At, B0); PG8_BAR; PG8_SCHED;
            PG8_STAGE(PG8_SB(1, 1), b3 + hstep, voffB);
            PG8_WAIT_V(6); PG8_BAR; PG8_MMA(1, 1, At, B1); PG8_BAR;
            }
        }
        if constexpr (ALIGN_EPI) { if (wr == 0) PG8_BAR; }
        if constexpr (!Epi::AFTER_DRAIN) { E(acc, cur, wr, wc, fr, fq); S.done(cur); }
        if (!has_next) break;
#pragma unroll
        for (int a = 0; a < 2; ++a)
#pragma unroll
            for (int b = 0; b < 2; ++b)
#pragma unroll
                for (int m = 0; m < 4; ++m)
#pragma unroll
                    for (int n = 0; n < 2; ++n) acc[a][b][m][n] = (f32x4){0.f, 0.f, 0.f, 0.f};
        cur = nxt; cA = nA; cB = nB; ++ui;
        if constexpr (ALIGN_EPI) { if (wr == 1) PG8_BAR; }
    }
    PG8_WAIT_V(0);
    if constexpr (!ALIGN_EPI) { if (wr == 0) PG8_BAR; }
    PG8_BAR;
    if constexpr (Epi::AFTER_DRAIN) { E.fused(acc, cur, wr, wc, fr, fq, lds, wid, lane); S.done(cur); }
#undef PG8_SA
#undef PG8_SB
#undef PG8_STAGE
#undef PG8_LDA
#undef PG8_LDB
#undef PG8_MMA
#undef PG8_WAIT_V
#undef PG8_WAIT_L
#undef PG8_BAR
#undef PG8_SCHED
}
}

namespace att {
#define ALAS __attribute__((address_space(3)))
typedef unsigned short bf16_t;
typedef short bf16x8 __attribute__((ext_vector_type(8)));
typedef short s16x4 __attribute__((ext_vector_type(4)));
typedef float f32x16 __attribute__((ext_vector_type(16)));
typedef float f32x4 __attribute__((ext_vector_type(4)));
typedef float f32x2_t __attribute__((ext_vector_type(2)));
typedef __bf16 bf16x2_t __attribute__((ext_vector_type(2)));
typedef unsigned u32x4 __attribute__((ext_vector_type(4)));
typedef unsigned u32x2 __attribute__((ext_vector_type(2)));
typedef short v4i16_t __attribute__((ext_vector_type(4)));
constexpr int TILE_B = 16384;
constexpr int STG_K = 0, STG_V = 2 * TILE_B, STG_B = 4 * TILE_B;
__device__ __forceinline__ int crow(int r, int h) { return (r & 3) + 8 * (r >> 2) + 4 * h; }
__device__ __forceinline__ unsigned cvtpk(float lo, float hi) { f32x2_t v = {lo, hi}; bf16x2_t b = __builtin_convertvector(v, bf16x2_t); return __builtin_bit_cast(unsigned, b); }
__device__ __forceinline__ float half_max(float v) { auto rr = __builtin_amdgcn_permlane32_swap(__float_as_uint(v), __float_as_uint(v), false, false); return fmaxf(__uint_as_float(rr[0]), __uint_as_float(rr[1])); }
__device__ __forceinline__ float half_sum(float v) { auto rr = __builtin_amdgcn_permlane32_swap(__float_as_uint(v), __float_as_uint(v), false, false); return __uint_as_float(rr[0]) + __uint_as_float(rr[1]); }
__device__ __forceinline__ s16x4 vtr(const ALAS unsigned char* p) { return __builtin_bit_cast(s16x4, __builtin_amdgcn_ds_read_tr16_b64_v4i16((ALAS v4i16_t*)p)); }

struct UnitDesc { const bf16_t* Q; const bf16_t* K; const bf16_t* V; bf16_t* O; int q0pos, nvalid, kv_len, s_hi, s_lo; float slope2; };

__device__ __forceinline__ void attn_unit(ALAS unsigned char* lds, const UnitDesc d, const float lam, const float* __restrict__ subg) {
    int tid = threadIdx.x; asm volatile("" : "+v"(tid));
    const int lane = tid & 63, w = __builtin_amdgcn_readfirstlane(tid >> 6), c = w >> 2, j = w & 3, r32 = lane & 31, hh = lane >> 5;
    const bool active = (32 * j < d.nvalid);
    const int qw0 = d.q0pos + 32 * j;
    const int td = active ? (qw0 >> 6) : -1;
    const int lrow = lane >> 4; const unsigned fsw = (((unsigned)lrow & 3u) << 2) | ((unsigned)w & 3u); const int gch = (int)(((unsigned)lane & 15u) ^ fsw);
    const bf16_t* kg = d.K + (size_t)(4 * w + lrow) * HW + gch * 8;
    const bf16_t* vg = d.V + (size_t)(4 * w + lrow) * HW + gch * 8;
#define ATT_DMA(s_, buf_) do { const size_t go_ = (size_t)(s_) * 128 * HW; ALAS unsigned char* lb_ = lds + (buf_) * STG_B + w * 1024; \
        _Pragma("unroll") for (int i_ = 0; i_ < 4; ++i_) { \
        __builtin_amdgcn_global_load_lds((const unsigned*)(kg + go_ + (size_t)i_ * 32 * HW), (ALAS unsigned*)(lb_ + STG_K + i_ * 8192), 16, 0, 0); \
        __builtin_amdgcn_global_load_lds((const unsigned*)(vg + go_ + (size_t)i_ * 32 * HW), (ALAS unsigned*)(lb_ + STG_V + i_ * 8192), 16, 0, 0); } } while (0)
    bf16x8 qf[4];
#pragma unroll
    for (int s = 0; s < 4; ++s) { if (active) qf[s] = *(const bf16x8*)(d.Q + (size_t)(32 * j + r32) * HW + c * 64 + 16 * s + 8 * hh); else qf[s] = (bf16x8){0, 0, 0, 0, 0, 0, 0, 0}; }
    unsigned koff[4];
    { const unsigned f = ((r32 & 3u) << 2) | ((r32 >> 2) & 3u);
#pragma unroll
      for (int s = 0; s < 4; ++s) koff[s] = 256u * r32 + 16u * (((unsigned)(8 * c + 2 * s + hh)) ^ f); }
    unsigned voff[2][4];
    { const unsigned qq = (lane & 15) >> 2, p = lane & 3, blk = (lane >> 4) & 1;
#pragma unroll
      for (int tt = 0; tt < 2; ++tt)
#pragma unroll
          for (int c4 = 0; c4 < 4; ++c4)
              voff[tt][c4] = 256u * (8 * tt + 4 * hh + qq) + 16u * ((((unsigned)c4 ^ qq) << 2) | (((2 * blk + (p >> 1)) ^ (unsigned)(2 * tt + hh)) & 3u)) + 8u * (p & 1); }
    float mref = 0.f, lsum = 0.f;
    f32x16 o[4];
#pragma unroll
    for (int c4 = 0; c4 < 4; ++c4)
#pragma unroll
        for (int i = 0; i < 16; ++i) o[c4][i] = 0.f;

    const int NI = d.s_hi - d.s_lo + 1;
    ATT_DMA(d.s_lo, 0);
    for (int it = 0; it < NI; ++it) {
        const int sg = d.s_lo + it;
        asm volatile("s_waitcnt vmcnt(0)" ::: "memory"); __syncthreads();
        if (it + 1 < NI) ATT_DMA(sg + 1, (it + 1) & 1);
        const ALAS unsigned char* Sb = lds + (it & 1) * STG_B;
#pragma unroll
        for (int tau = 0; tau < 2; ++tau) {
            const int t = 2 * sg + tau;
            if (t <= td) {
                const ALAS unsigned char* Kb = Sb + STG_K + tau * TILE_B; const ALAS unsigned char* Vb = Sb + STG_V + tau * TILE_B;
                f32x16 s0, s1;
                if (t == td) {
                    const int qpos = qw0 + r32; const float rc = d.slope2 * (float)r32 - mref;
#pragma unroll
                    for (int i = 0; i < 16; ++i) { const int k0 = 64 * t + crow(i, hh), k1 = k0 + 32;
                        const int d0 = qpos - k0, d1 = qpos - k1;
                        s0[i] = k0 < d.kv_len ? rc - d.slope2 * (float)(d0 < 0 ? -d0 : d0) : -1e30f;
                        s1[i] = k1 < d.kv_len ? rc - d.slope2 * (float)(d1 < 0 ? -d1 : d1) : -1e30f; }
                } else {
                    const float b0 = d.slope2 * (float)(64 * t - qw0 + 4 * hh) - mref, b1 = b0 + 32.f * d.slope2;
#pragma unroll
                    for (int i = 0; i < 16; ++i) { const float ci = (float)((i & 3) + 8 * (i >> 2)); s0[i] = __builtin_fmaf(d.slope2, ci, b0); s1[i] = __builtin_fmaf(d.slope2, ci, b1); }
                }
                bf16x8 kf[8];
#pragma unroll
                for (int s = 0; s < 4; ++s) { kf[2 * s] = *(const ALAS bf16x8*)(Kb + koff[s]); kf[2 * s + 1] = *(const ALAS bf16x8*)(Kb + koff[s] + 8192); }
                __builtin_amdgcn_sched_barrier(0);
#pragma unroll
                for (int s = 0; s < 4; ++s) {
                    s0 = __builtin_amdgcn_mfma_f32_32x32x16_bf16(kf[2 * s], qf[s], s0, 0, 0, 0);
                    s1 = __builtin_amdgcn_mfma_f32_32x32x16_bf16(kf[2 * s + 1], qf[s], s1, 0, 0, 0);
                }
                s16x4 vl[2][4], vh[2][4];
#define ATT_VLD(bsel_, ks_) do { _Pragma("unroll") for (int c4 = 0; c4 < 4; ++c4) { vl[bsel_][c4] = vtr(Vb + voff[0][c4] + 4096 * (ks_)); vh[bsel_][c4] = vtr(Vb + voff[1][c4] + 4096 * (ks_)); } } while (0)
                ATT_VLD(0, 0);
                __builtin_amdgcn_sched_barrier(0);
                float pm = 0.f, ps = 0.f;
#pragma unroll
                for (int i = 0; i < 16; ++i) { s0[i] = __builtin_amdgcn_exp2f(s0[i]); s1[i] = __builtin_amdgcn_exp2f(s1[i]); }
#pragma unroll
                for (int i = 0; i < 16; i += 2) pm = fmaxf(fmaxf(pm, fmaxf(s0[i], s0[i + 1])), fmaxf(s1[i], s1[i + 1]));
                if (__builtin_expect(__any(pm > 256.f), 0)) {
                    pm = half_max(pm);
                    const float dl = pm > 1.f ? ceilf(__builtin_amdgcn_logf(pm)) : 0.f, f = __builtin_amdgcn_exp2f(-dl);
                    mref += dl; lsum *= f;
#pragma unroll
                    for (int i = 0; i < 16; ++i) { s0[i] *= f; s1[i] *= f; }
#pragma unroll
                    for (int c4 = 0; c4 < 4; ++c4)
#pragma unroll
                        for (int i = 0; i < 16; ++i) o[c4][i] *= f;
                }
#pragma unroll
                for (int i = 0; i < 16; ++i) ps += s0[i] + s1[i];
                lsum += ps;
                bf16x8 pf[4];
#pragma unroll
                for (int s = 0; s < 2; ++s) {
                    u32x4 a, b;
                    a.x = cvtpk(s0[8 * s], s0[8 * s + 1]); a.y = cvtpk(s0[8 * s + 2], s0[8 * s + 3]); a.z = cvtpk(s0[8 * s + 4], s0[8 * s + 5]); a.w = cvtpk(s0[8 * s + 6], s0[8 * s + 7]);
                    b.x = cvtpk(s1[8 * s], s1[8 * s + 1]); b.y = cvtpk(s1[8 * s + 2], s1[8 * s + 3]); b.z = cvtpk(s1[8 * s + 4], s1[8 * s + 5]); b.w = cvtpk(s1[8 * s + 6], s1[8 * s + 7]);
                    pf[s] = __builtin_bit_cast(bf16x8, a); pf[2 + s] = __builtin_bit_cast(bf16x8, b);
                }
#pragma unroll
                for (int ks = 0; ks < 4; ++ks) {
                    if (ks < 3) ATT_VLD((ks + 1) & 1, ks + 1);
                    __builtin_amdgcn_sched_barrier(0);
#pragma unroll
                    for (int c4 = 0; c4 < 4; ++c4) {
                        const s16x4 lo = vl[ks & 1][c4], hi = vh[ks & 1][c4];
                        const bf16x8 vt = (bf16x8){lo[0], lo[1], lo[2], lo[3], hi[0], hi[1], hi[2], hi[3]};
                        o[c4] = __builtin_amdgcn_mfma_f32_32x32x16_bf16(vt, pf[ks], o[c4], 0, 0, 0);
                    }
                    __builtin_amdgcn_sched_barrier(0);
                }
#undef ATT_VLD
            }
        }
    }
    __syncthreads();
    const float ltot = half_sum(lsum), inv = active ? 1.f / ltot : 0.f;
    ALAS float* xch = (ALAS float*)lds + j * 4096;
    if (c == 1 && active) {
#pragma unroll
        for (int c4 = 0; c4 < 4; ++c4)
#pragma unroll
            for (int i = 0; i < 16; ++i) xch[(c4 * 16 + i) * 64 + lane] = o[c4][i] * inv;
    }
    __syncthreads();
    if (c == 0 && active) {
        float ss = 0.f;
#pragma unroll
        for (int c4 = 0; c4 < 4; ++c4)
#pragma unroll
            for (int i = 0; i < 16; ++i) { const float v = o[c4][i] * inv - lam * xch[(c4 * 16 + i) * 64 + lane]; o[c4][i] = v; ss += v * v; }
        ss = half_sum(ss);
        const float rs = 0.8f / sqrtf(ss * (1.f / 128.f) + EPS);
        bf16_t* op = d.O + (size_t)(32 * j + r32) * DM + 4 * hh;
#pragma unroll
        for (int c4 = 0; c4 < 4; ++c4)
#pragma unroll
            for (int g4 = 0; g4 < 4; ++g4) { const int dv0 = 32 * c4 + 8 * g4;
                const f32x4 g = *(const f32x4*)(subg + dv0 + 4 * hh);
                u32x2 pk; pk.x = cvtpk(o[c4][4 * g4] * rs * g[0], o[c4][4 * g4 + 1] * rs * g[1]); pk.y = cvtpk(o[c4][4 * g4 + 2] * rs * g[2], o[c4][4 * g4 + 3] * rs * g[3]);
                *(u32x2*)(op + dv0) = pk; }
    }
    __syncthreads();
}
#undef ATT_DMA
#undef ALAS
}

#define GAS __attribute__((address_space(1)))
#define LAS __attribute__((address_space(3)))
typedef unsigned short bf16;
typedef unsigned v4u __attribute__((ext_vector_type(4)));
typedef unsigned v2u __attribute__((ext_vector_type(2)));
typedef float f32x4 __attribute__((ext_vector_type(4)));
constexpr int NWAVES = 8, NTHREADS = 512;
constexpr int LDS_BYTES = 147456;
constexpr size_t MiB = 1u << 20;
constexpr size_t WS_MOD = 0;
constexpr size_t WS_QCTR = 1 * MiB + 16384, WS_MAXB = 1 * MiB + 32768;
constexpr size_t WS_BAR = 1 * MiB;
constexpr size_t WS_ROWSS = 1 * MiB + 65536;
constexpr size_t WS_SH2 = 30 * MiB;
constexpr size_t WS_BIAS2 = 26 * MiB;
constexpr size_t CTL_BYTES = 65536 + (size_t)MT * 4;
constexpr int MISC_OFF = 131072 + 320;
constexpr size_t WS_WIN = 2 * MiB, WS_WO = 8 * MiB, WS_W1 = 10 * MiB, WS_W2 = 18 * MiB;
constexpr size_t WS_XN = 32 * MiB;
constexpr size_t WS_HB = 192 * MiB;
constexpr size_t WS_BG = 192 * MiB, WS_CG = 257 * MiB, WS_UG = 322 * MiB, WS_QB = 387 * MiB;
constexpr size_t WS_KB = 452 * MiB, WS_VB = 550 * MiB;
constexpr size_t WS_MIX = 648 * MiB;
constexpr size_t WS_END = 778 * MiB;
static_assert((size_t)MT * HW * 2 <= 65 * MiB && (size_t)KVROWS * HW * 2 <= 98 * MiB && (size_t)MT * DM * 2 <= 130 * MiB && (size_t)MT * FF * 2 <= 520 * MiB, "ws map");

__device__ __forceinline__ unsigned f2bf(float f) { unsigned u = __builtin_bit_cast(unsigned, f); return (u + 0x7fffu + ((u >> 16) & 1u)) >> 16; }
__device__ __forceinline__ unsigned pk2(float lo, float hi) { return f2bf(lo) | (f2bf(hi) << 16); }
__device__ __forceinline__ float bflo(unsigned u) { return __builtin_bit_cast(float, u << 16); }
__device__ __forceinline__ float bfhi(unsigned u) { return __builtin_bit_cast(float, u & 0xffff0000u); }
__device__ __forceinline__ float wave_sum(float v) {
#pragma unroll
    for (int o = 1; o < 64; o <<= 1) v += __shfl_xor(v, o);
    return v;
}
#define LDS_WAIT() asm volatile("s_waitcnt lgkmcnt(0)" ::: "memory")

#define XB_TMO      128
#define XB_XCNT(j)  (256  + 64 * (j))
#define XB_XSUB(j)  (1280 + 64 * (j))
#define XB_XGEN(j)  (2304 + 64 * (j))
#define XB_TOP      3328
#define XB_TOPGEN   3392
#define XCD_BAR_WORDS 3456
#define XB_SPIN_CAP (1u << 18)

__device__ __forceinline__ unsigned xb_ld(unsigned* p)              { return __hip_atomic_load(p, __ATOMIC_RELAXED, __HIP_MEMORY_SCOPE_AGENT); }
__device__ __forceinline__ unsigned xb_add(unsigned* p, unsigned v) { return __hip_atomic_fetch_add(p, v, __ATOMIC_RELAXED, __HIP_MEMORY_SCOPE_AGENT); }
__device__ __forceinline__ unsigned xb_xcc_id() { return (unsigned)__builtin_amdgcn_s_getreg((3 << 11) | 20) & 0xFu; }
#define XB_SPIN(cond, bar) do { unsigned _sp = 0; while (cond) { __builtin_amdgcn_s_sleep(1); \
    if ((++_sp & 255u) == 0u) { if (xb_ld(&(bar)[XB_TMO])) break; if (_sp > XB_SPIN_CAP) { atomicAdd(&(bar)[XB_TMO], 1u); break; } } } } while (0)

struct XcdBarrier {
    unsigned* bar; unsigned x;
    volatile LAS unsigned* st;
};

__device__ __forceinline__ XcdBarrier xcd_barrier_post(unsigned* bar, volatile LAS unsigned* st) {
    XcdBarrier b; b.bar = bar; b.x = xb_xcc_id(); b.st = st;
    if (threadIdx.x == 0) (void)xb_add(&bar[XB_XCNT(b.x)], 1u);
    return b;
}
__device__ __forceinline__ void xcd_barrier_complete(unsigned* bar, unsigned x, unsigned& nloc, unsigned& nx) {
    const unsigned G = gridDim.x * gridDim.y * gridDim.z;
    unsigned sum, cnt, mine, sp = 0u;
    for (;;) {
        sum = 0u; cnt = 0u; mine = 0u;
#pragma unroll
        for (unsigned j = 0; j < 16; ++j) { const unsigned c = xb_ld(&bar[XB_XCNT(j)]); sum += c; cnt += (c > 0u) ? 1u : 0u; mine = (j == x) ? c : mine; }
        if (sum == G) break;
        __builtin_amdgcn_s_sleep(1);
        if ((++sp & 255u) == 0u) { if (xb_ld(&bar[XB_TMO])) break; if (sp > XB_SPIN_CAP) { atomicAdd(&bar[XB_TMO], 1u); break; } }
    }
    nloc = mine > 0u ? mine : 1u; nx = cnt > 0u ? cnt : 1u;
}

__device__ __forceinline__ void xcd_barrier(const XcdBarrier& b) {
    asm volatile("s_waitcnt vmcnt(0)" ::: "memory");
    __syncthreads();
    if (threadIdx.x == 0) {
        unsigned* bar = b.bar;
        __builtin_amdgcn_s_waitcnt(0);
        unsigned nloc = b.st[0], nx = b.st[1];
        if (nloc == 0u) { xcd_barrier_complete(bar, b.x, nloc, nx); b.st[0] = nloc; b.st[1] = nx; }
        const unsigned old = xb_add(&bar[XB_XSUB(b.x)], 1u);
        const unsigned gen = old / nloc;
        if (old + 1u == (gen + 1u) * nloc) {
            __builtin_amdgcn_fence(__ATOMIC_RELEASE, "agent");
            asm volatile("s_waitcnt vmcnt(0)" ::: "memory");
            const unsigned og = xb_add(&bar[XB_TOP], 1u);
            const unsigned tg = og / nx;
            if (og + 1u == (tg + 1u) * nx) xb_add(&bar[XB_TOPGEN], 1u);
            else XB_SPIN(xb_ld(&bar[XB_TOPGEN]) == tg, bar);
            __builtin_amdgcn_fence(__ATOMIC_ACQUIRE, "agent");
            xb_add(&bar[XB_XGEN(b.x)], 1u);
            asm volatile("s_waitcnt vmcnt(0)" ::: "memory");
        } else {
            XB_SPIN(xb_ld(&bar[XB_XGEN(b.x)]) == gen, bar);
            __builtin_amdgcn_fence(__ATOMIC_ACQUIRE, "agent");
            asm volatile("s_waitcnt vmcnt(0)" ::: "memory");
        }
    }
    __syncthreads();
}


struct Args {
    const float *x_p, *x_s, *cache_k, *cache_v, *state_conv, *c_p, *c_s, *norm1_g, *norm2_g, *w_ada, *b_ada, *w_in, *conv_w, *lq1, *lk1, *lq2, *lk2, *subln_g, *w_o, *w_mlp1, *w_mlp2, *final_g;
    float* out; unsigned char* ws; int never; int pad;
};

__device__ __forceinline__ void p0_transpose_item(const float* W, int K, int N, bf16* WT, LAS float* scr, int item, int lane) {
    const int nblk = N / 32, kb = item / nblk, nb = item % nblk, k0 = 64 * kb, n0 = 32 * nb;
#pragma unroll 8
    for (int i = 0; i < 32; ++i) { const int kk = 2 * i + (lane >> 5); scr[kk * 33 + (lane & 31)] = W[(size_t)(k0 + kk) * N + n0 + (lane & 31)]; }
    LDS_WAIT(); asm volatile("" ::: "memory");
    const int c = lane & 7;
#pragma unroll
    for (int j = 0; j < 4; ++j) { const int n = (lane >> 3) + 8 * j; const LAS float* s = scr + (8 * c) * 33 + n;
        v4u o; o.x = pk2(s[0 * 33], s[1 * 33]); o.y = pk2(s[2 * 33], s[3 * 33]); o.z = pk2(s[4 * 33], s[5 * 33]); o.w = pk2(s[6 * 33], s[7 * 33]);
        *(GAS v4u*)(WT + (size_t)(n0 + n) * K + k0 + 8 * c) = o; }
    LDS_WAIT(); asm volatile("" ::: "memory");
}

__device__ __forceinline__ void norm_mod_row(const float* xrow, const float* g, const float* sc, const float* sh, bf16* orow, int lane) {
    const f32x4* xr = (const f32x4*)xrow + lane;
    f32x4 v[4]; float s = 0.f;
#pragma unroll
    for (int j = 0; j < 4; ++j) { v[j] = xr[64 * j]; s += (v[j].x * v[j].x + v[j].y * v[j].y) + (v[j].z * v[j].z + v[j].w * v[j].w); }
    const float rstd = 1.f / sqrtf(wave_sum(s) * (1.f / DM) + EPS);
    unsigned long long* o8 = (unsigned long long*)orow + lane;
#pragma unroll
    for (int j = 0; j < 4; ++j) { const f32x4 gg = ((const f32x4*)g)[lane + 64 * j], cc = ((const f32x4*)sc)[lane + 64 * j], hh = ((const f32x4*)sh)[lane + 64 * j];
        const f32x4 r = v[j] * rstd * gg * (cc + 1.f) + hh;
        o8[64 * j] = (unsigned long long)pk2(r.x, r.y) | ((unsigned long long)pk2(r.z, r.w) << 32); }
}

__global__ void __launch_bounds__(NTHREADS, 2) mega_fwd(Args a) {
    extern __shared__ __attribute__((aligned(16))) unsigned char lds_raw[];
    LAS unsigned char* lds = (LAS unsigned char*)lds_raw;
    cg::grid_group grid = cg::this_grid();
    const int G = gridDim.x; const int bx = blockIdx.x;
    const int vcu = (G % 8 == 0) ? (bx % 8) * (G / 8) + bx / 8 : bx;
    const int NGW = G * NWAVES;
#define PHASE_IDS() int tid_ = threadIdx.x; asm volatile("" : "+v"(tid_)); const int tid = tid_, lane = tid & 63, wave = __builtin_amdgcn_readfirstlane(tid >> 6), gw = vcu * NWAVES + wave; (void)tid; (void)lane; (void)gw
    unsigned char* ws = a.ws;
    float* mod = (float*)(ws + WS_MOD); float* rowss = (float*)(ws + WS_ROWSS); float* bias2 = (float*)(ws + WS_BIAS2); bf16* SH2 = (bf16*)(ws + WS_SH2);
    bf16 *Win_t = (bf16*)(ws + WS_WIN), *Wo_t = (bf16*)(ws + WS_WO), *W1_t = (bf16*)(ws + WS_W1), *W2_t = (bf16*)(ws + WS_W2);
    bf16 *XN = (bf16*)(ws + WS_XN), *HB = (bf16*)(ws + WS_HB), *BG = (bf16*)(ws + WS_BG), *CG = (bf16*)(ws + WS_CG), *UG = (bf16*)(ws + WS_UG), *QB = (bf16*)(ws + WS_QB);
    bf16 *KB = (bf16*)(ws + WS_KB), *VB = (bf16*)(ws + WS_VB), *MIX = (bf16*)(ws + WS_MIX);
    volatile LAS unsigned* MISC = (volatile LAS unsigned*)(lds + MISC_OFF);
    if (threadIdx.x < 32) MISC[threadIdx.x] = 0u;
    unsigned* barw = (unsigned*)(ws + WS_BAR);
    unsigned* qctr = (unsigned*)(ws + WS_QCTR); unsigned* maxbuf = (unsigned*)(ws + WS_MAXB);
    __syncthreads();
    const XcdBarrier bar = xcd_barrier_post(barw, MISC + 8);
#define GRID_SYNC() xcd_barrier(bar)
    if (a.never) grid.sync();

    { PHASE_IDS();
    if (bx < (6 * DM) / 64) {
        const int cb = bx * 64;
        LAS float* sl = (LAS float*)lds + wave * (64 * NMOD);
        float acc[NMOD];
#pragma unroll
        for (int r = 0; r < NMOD; ++r) acc[r] = 0.f;
        for (int half = 0; half < 2; ++half) {
            const int k0 = wave * 128 + half * 64;
            for (int idx = lane; idx < 64 * NMOD; idx += 64) { const int kk = idx & 63, r = idx >> 6;
                const float cv = r < NB_P ? a.c_p[r * DM + k0 + kk] : a.c_s[(r - NB_P) * DM + k0 + kk];
                sl[kk * NMOD + r] = cv / (1.f + __expf(-cv)); }
            LDS_WAIT(); asm volatile("" ::: "memory");
            for (int kk = 0; kk < 64; ++kk) {
                const float wv = a.w_ada[(size_t)(k0 + kk) * (6 * DM) + cb + lane];
                const LAS f32x4* sp = (const LAS f32x4*)(sl + kk * NMOD);
#pragma unroll
                for (int r4 = 0; r4 < NMOD / 4; ++r4) { const f32x4 sv = sp[r4]; acc[4 * r4] += sv.x * wv; acc[4 * r4 + 1] += sv.y * wv; acc[4 * r4 + 2] += sv.z * wv; acc[4 * r4 + 3] += sv.w * wv; }
            }
            LDS_WAIT(); asm volatile("" ::: "memory");
        }
        __syncthreads();
        LAS float* red = (LAS float*)lds;
#pragma unroll
        for (int r = 0; r < NMOD; ++r) red[(wave * NMOD + r) * 64 + lane] = acc[r];
        __syncthreads();
        for (int idx = tid; idx < NMOD * 64; idx += NTHREADS) { const int r = idx >> 6, cl = idx & 63; float s = a.b_ada[cb + cl];
#pragma unroll
            for (int w8 = 0; w8 < 8; ++w8) s += red[(w8 * NMOD + r) * 64 + cl];
            mod[(size_t)r * (6 * DM) + cb + cl] = s; }
        __syncthreads();
    }
    {
        LAS float* scr = (LAS float*)(lds + wave * 16384);
        constexpr int I_IN = (DM / 64) * (INW / 32), I_O = (DM / 64) * (DM / 32), I_1 = (DM / 64) * (FF / 32), I_2 = (FF / 64) * (DM / 32);
        constexpr int NITEMS = I_IN + I_O + I_1 + I_2;
        for (int it = gw; it < NITEMS; it += NGW) {
            int r = it;
            if (r < I_IN) { p0_transpose_item(a.w_in, DM, INW, Win_t, scr, r, lane); continue; } r -= I_IN;
            if (r < I_O) { p0_transpose_item(a.w_o, DM, DM, Wo_t, scr, r, lane); continue; } r -= I_O;
            if (r < I_1) { p0_transpose_item(a.w_mlp1, DM, FF, W1_t, scr, r, lane); continue; } r -= I_1;
            p0_transpose_item(a.w_mlp2, FF, DM, W2_t, scr, r, lane);
        }
        constexpr int NC = NB_S * PAST;
        for (int it = gw; it < 2 * NC; it += NGW) {
            const int which = it >= NC, r = which ? it - NC : it, b = r >> 10, t = r & 1023;
            const float* src = (which ? a.cache_v : a.cache_k) + (size_t)r * HW + lane * 8;
            const f32x4 v0 = *(const f32x4*)src, v1 = *(const f32x4*)(src + 4);
            v4u o; o.x = pk2(v0.x, v0.y); o.y = pk2(v0.z, v0.w); o.z = pk2(v1.x, v1.y); o.w = pk2(v1.z, v1.w);
            *(v4u*)((which ? VB : KB) + (size_t)(MP + b * KVS + t) * HW + lane * 8) = o;
        }
        for (int it = gw; it < 2 * NB_S * 32; it += NGW) {
            const int which = it >= NB_S * 32, r = which ? it - NB_S * 32 : it, b = r >> 5, t = PAST + T_S + (r & 31);
            *(v4u*)((which ? VB : KB) + (size_t)(MP + b * KVS + t) * HW + lane * 8) = (v4u){0u, 0u, 0u, 0u};
        }
    }
    }
    GRID_SYNC();

    { PHASE_IDS();
    if (gw < 256) { unsigned long long* o8 = (unsigned long long*)(SH2 + (size_t)gw * DM) + lane; const f32x4* sp = (const f32x4*)(mod + (size_t)(gw < NMOD ? gw : 0) * (6 * DM) + 3 * DM) + lane;
#pragma unroll
        for (int j = 0; j < 4; ++j) { f32x4 r = sp[64 * j]; if (gw >= NMOD) r = (f32x4){0.f, 0.f, 0.f, 0.f}; o8[64 * j] = (unsigned long long)pk2(r.x, r.y) | ((unsigned long long)pk2(r.z, r.w) << 32); } }
    for (int m = gw; m < MT; m += NGW) {
        const int mrow = m < MP ? (m >> 13) : NB_P + ((m - MP) >> 5);
        const float* xr = m < MP ? a.x_p + (size_t)m * DM : a.x_s + (size_t)(m - MP) * DM;
        const float* mr = mod + (size_t)mrow * (6 * DM);
        norm_mod_row(xr, a.norm1_g, mr + DM, mr, XN + (size_t)m * DM, lane);
    } }
    GRID_SYNC();

    {
        pg8::Gemm g{XN, Win_t, MT, INW, DM}; pg8::StaticOrder S; S.init(MT, INW, G, bx);
        pg8::EpiIn E{BG, CG, UG, QB, KB, VB, a.out, maxbuf};
        pg8::gemm_phase<pg8::EpiIn, pg8::StaticOrder, true, true>(lds, g, S, E);
    }
    GRID_SYNC();

    { PHASE_IDS();
        float lam;
        { float d1 = 0.f, d2 = 0.f; for (int i = 0; i < 64; ++i) { d1 += a.lq1[i] * a.lk1[i]; d2 += a.lq2[i] * a.lk2[i]; } lam = __expf(d1) - __expf(d2) + 0.2f; }
        constexpr int NQI = 256 + (NB_S * 4) / 8;
        int qi = (int)(bar.x & 7u);
        for (int nq = 0; nq < 8;) {
            if (tid == 0) MISC[0] = __hip_atomic_fetch_add(qctr + 64 * qi, 1u, __ATOMIC_RELAXED, __HIP_MEMORY_SCOPE_AGENT);
            __syncthreads();
            const int idx = (int)MISC[0];
            __syncthreads();
            if (idx >= NQI) { qi = (qi + 1) & 7; ++nq; continue; }
            att::UnitDesc d;
            if (idx < 256) {
                const int b = qi, h = 3 - (idx >> 6), qb = 63 - (idx & 63);
                const size_t row0 = (size_t)b * T_P + 128 * qb;
                d.Q = QB + row0 * HW + h * 128; d.K = KB + (size_t)b * T_P * HW + h * 128; d.V = VB + (size_t)b * T_P * HW + h * 128; d.O = MIX + row0 * DM + 512 + h * 128;
                d.q0pos = 128 * qb; d.nvalid = 128; d.kv_len = T_P; d.s_hi = qb; d.slope2 = LOG2E * exp2f(-2.f * (float)(h + 1));
                const unsigned* mq = maxbuf + b * 16 + h * 4; const unsigned* mk = mq + 128;
                const float B0 = sqrtf(__uint_as_float(mq[0]) * __uint_as_float(mk[0])) + sqrtf(__uint_as_float(mq[1]) * __uint_as_float(mk[1]));
                const float B1 = sqrtf(__uint_as_float(mq[2]) * __uint_as_float(mk[2])) + sqrtf(__uint_as_float(mq[3]) * __uint_as_float(mk[3]));
                const float Tn = 2.04f * fmaxf(B0, B1) + 160.f, X = ((float)d.q0pos - 127.f - Tn / d.slope2) * (1.f / 128.f);
                int slo = X > 0.f ? (int)floorf(X) : 0; d.s_lo = slo < qb ? slo : qb;
            } else {
                const int us = qi * ((NB_S * 4) / 8) + idx - 256, b = us >> 2, h = us & 3;
                const size_t row0 = (size_t)MP + b * T_S, kr0 = (size_t)MP + (size_t)b * KVS;
                d.Q = QB + row0 * HW + h * 128; d.K = KB + kr0 * HW + h * 128; d.V = VB + kr0 * HW + h * 128; d.O = MIX + row0 * DM + 512 + h * 128;
                d.q0pos = PAST; d.nvalid = T_S; d.kv_len = PAST + T_S; d.s_hi = (KVS / 64) / 2; d.s_lo = 0; d.slope2 = LOG2E * exp2f(-2.f * (float)(h + 1));
            }
            att::attn_unit(lds, d, lam, a.subln_g);
        }
        const int ch0 = lane * 8;
        float w0[8], w1[8], w2[8];
#pragma unroll
        for (int e = 0; e < 8; ++e) { w0[e] = a.conv_w[ch0 + e]; w1[e] = a.conv_w[HW + ch0 + e]; w2[e] = a.conv_w[2 * HW + ch0 + e]; }
        for (int r = gw; r < MT; r += NGW) {
            const bool smp = r >= MP; const int t = smp ? ((r - MP) & 31) : (r & (T_P - 1)), T = smp ? T_S : T_P, b = smp ? ((r - MP) >> 5) : (r >> 13);
            float uc[3][8];
#pragma unroll
            for (int k = 0; k < 3; ++k) {
                if (t - k >= 0) { const v4u cv = *(const v4u*)(CG + (size_t)(r - k) * HW + ch0), uv = *(const v4u*)(UG + (size_t)(r - k) * HW + ch0);
                    uc[k][0] = bflo(cv.x) * bflo(uv.x); uc[k][1] = bfhi(cv.x) * bfhi(uv.x); uc[k][2] = bflo(cv.y) * bflo(uv.y); uc[k][3] = bfhi(cv.y) * bfhi(uv.y);
                    uc[k][4] = bflo(cv.z) * bflo(uv.z); uc[k][5] = bfhi(cv.z) * bfhi(uv.z); uc[k][6] = bflo(cv.w) * bflo(uv.w); uc[k][7] = bfhi(cv.w) * bfhi(uv.w);
                } else if (smp) { const float* sp = a.state_conv + ((size_t)b * 2 + (2 + t - k)) * HW + ch0; const f32x4 s0 = *(const f32x4*)sp, s1 = *(const f32x4*)(sp + 4);
                    uc[k][0] = s0.x; uc[k][1] = s0.y; uc[k][2] = s0.z; uc[k][3] = s0.w; uc[k][4] = s1.x; uc[k][5] = s1.y; uc[k][6] = s1.z; uc[k][7] = s1.w;
                } else {
#pragma unroll
                    for (int e = 0; e < 8; ++e) uc[k][e] = 0.f; }
            }
            const v4u bv = *(const v4u*)(BG + (size_t)r * HW + ch0);
            float bb[8] = {bflo(bv.x), bfhi(bv.x), bflo(bv.y), bfhi(bv.y), bflo(bv.z), bfhi(bv.z), bflo(bv.w), bfhi(bv.w)};
            float y[8];
#pragma unroll
            for (int e = 0; e < 8; ++e) y[e] = bb[e] * (w0[e] * uc[2][e] + w1[e] * uc[1][e] + w2[e] * uc[0][e]);
            v4u o; o.x = pk2(y[0], y[1]); o.y = pk2(y[2], y[3]); o.z = pk2(y[4], y[5]); o.w = pk2(y[6], y[7]);
            *(v4u*)(MIX + (size_t)r * DM + ch0) = o;
            if (t >= T - 2) { float* cp = a.out + (smp ? O_CS : O_CP) + ((size_t)b * 2 + (t - (T - 2))) * HW + ch0;
                *(f32x4*)cp = (f32x4){uc[0][0], uc[0][1], uc[0][2], uc[0][3]}; *(f32x4*)(cp + 4) = (f32x4){uc[0][4], uc[0][5], uc[0][6], uc[0][7]}; }
        }
    }
    GRID_SYNC();

    {
        pg8::Gemm g{MIX, Wo_t, MT, DM, DM}; pg8::StaticOrder S; S.init(MT, DM, G, bx);
        pg8::EpiResGate2 E{a.x_p, a.x_s, a.out, mod + 2 * DM, mod + 4 * DM, a.norm2_g, XN, rowss};
        pg8::gemm_phase<pg8::EpiResGate2, pg8::StaticOrder, true, true>(lds, g, S, E);
        const int c2 = G >= 48 ? bx - 16 : bx;
        if (c2 >= 0 && c2 < 16) { pg8::Gemm gb{SH2, W1_t, 256, FF, DM, 0}; pg8::SplitOrder Sb{1, FF / 256, 1, 1, 16, c2};
            pg8::EpiPartial Eb{bias2, 1, 256, FF};
            pg8::gemm_phase<pg8::EpiPartial, pg8::SplitOrder, true, true>(lds, gb, Sb, Eb); }
    }
    GRID_SYNC();

    {
        pg8::Gemm g{XN, W1_t, MT, FF, DM}; pg8::StaticOrder S; S.init(MT, FF, G, bx);
        pg8::EpiRelu2N E{HB, FF, rowss, bias2};
        pg8::gemm_phase<pg8::EpiRelu2N, pg8::StaticOrder, true, true>(lds, g, S, E);
    }
    GRID_SYNC();

    {
        pg8::Gemm g{HB, W2_t, MP, DM, FF}; pg8::StaticOrder S; S.init(MP, DM, G, bx);
        pg8::EpiResGate E{a.out, a.out + (size_t)MP * DM, a.out, mod + 5 * DM};
        pg8::gemm_phase<pg8::EpiResGate, pg8::StaticOrder, true, true>(lds, g, S, E);
        pg8::Gemm g2{HB + (size_t)MP * FF, W2_t, MS, DM, FF, 256}; pg8::SplitOrder S2{MS / 256, DM / 256, FF / 256, 256, G, bx};
        pg8::EpiPartial E2{(float*)(ws + WS_XN), 256, MS, DM};
        pg8::gemm_phase<pg8::EpiPartial, pg8::SplitOrder, true, true>(lds, g2, S2, E2);
    }
    GRID_SYNC();

    { PHASE_IDS();
    for (int m = gw; m < MT; m += NGW) {
        f32x4* xr = (f32x4*)(a.out + (size_t)m * DM) + lane;
        f32x4 v[4]; float s = 0.f;
#pragma unroll
        for (int j = 0; j < 4; ++j) v[j] = xr[64 * j];
        if (m >= MP) {
            const f32x4* pp = (const f32x4*)(ws + WS_XN) + (size_t)(m - MP) * (DM / 4) + lane; const f32x4* gp = (const f32x4*)(mod + (size_t)(NB_P + ((m - MP) >> 5)) * (6 * DM) + 5 * DM) + lane;
#pragma unroll
            for (int j = 0; j < 4; ++j) { f32x4 t = pp[64 * j];
                for (int s2 = 1; s2 < FF / 256; ++s2) t += pp[(size_t)s2 * MS * (DM / 4) + 64 * j];
                v[j] += gp[64 * j] * t; }
        }
#pragma unroll
        for (int j = 0; j < 4; ++j) s += (v[j].x * v[j].x + v[j].y * v[j].y) + (v[j].z * v[j].z + v[j].w * v[j].w);
        const float rstd = 1.f / sqrtf(wave_sum(s) * (1.f / DM) + EPS);
#pragma unroll
        for (int j = 0; j < 4; ++j) xr[64 * j] = v[j] * rstd * ((const f32x4*)a.final_g)[lane + 64 * j];
    } }
}

extern "C" void kernel_launch(void* const* d_in, const int* in_sizes, int n_in, void* d_out, int out_size, void* d_ws, size_t ws_size, hipStream_t stream) {
    static int grid = 0;
    if (grid == 0) {
        if (n_in != 22 || in_sizes[0] != MP * DM || (size_t)out_size != O_END || ws_size < WS_END) {
            fprintf(stderr, "kernel_launch: unexpected shapes: n_in %d in0 %d out %d ws %zu (need %zu)\n", n_in, n_in > 0 ? in_sizes[0] : -1, out_size, ws_size, (size_t)WS_END); grid = -1; return; }
        int dev = 0, cus = 0, per_cu = 0;
        (void)hipGetDevice(&dev); (void)hipDeviceGetAttribute(&cus, hipDeviceAttributeMultiprocessorCount, dev);
        if (hipFuncSetAttribute((const void*)mega_fwd, hipFuncAttributeMaxDynamicSharedMemorySize, LDS_BYTES) != hipSuccess) { fprintf(stderr, "kernel_launch: hipFuncSetAttribute failed\n"); grid = -1; return; }
        if (hipOccupancyMaxActiveBlocksPerMultiprocessor(&per_cu, (const void*)mega_fwd, NTHREADS, LDS_BYTES) != hipSuccess || per_cu < 1) { fprintf(stderr, "kernel_launch: occupancy query says %d\n", per_cu); per_cu = 1; }
        (void)hipGetLastError();
        grid = cus * per_cu;
        fprintf(stderr, "kernel_launch: grid %d (cus %d x %d)\n", grid, cus, per_cu);
    }
    if (grid < 0) return;
    Args a{};
    const float** p = (const float**)&a;
    for (int i = 0; i < 22; ++i) p[i] = (const float*)d_in[i];
    a.out = (float*)d_out; a.ws = (unsigned char*)d_ws;
    if (hipMemsetAsync((char*)d_ws + WS_BAR, 0, CTL_BYTES, stream) != hipSuccess) { fprintf(stderr, "kernel_launch: hipMemsetAsync failed\n"); return; }
    void* args[] = {&a};
    hipError_t e = hipLaunchCooperativeKernel((const void*)mega_fwd, dim3(grid), dim3(NTHREADS), args, LDS_BYTES, stream);
    if (e != hipSuccess) fprintf(stderr, "kernel_launch: cooperative launch failed: %s (grid %d)\n", hipGetErrorString(e), grid);
}
```

```cpp
#include <hip/hip_runtime.h>
#include <hip/hip_cooperative_groups.h>
#include <cstdio>
#include <cstdint>
namespace cg = cooperative_groups;

constexpr int DM = 1024, NB_P = 8, T_P = 8192, NB_S = 32, T_S = 32, PAST = 1024;
constexpr int MP = NB_P * T_P, MS = NB_S * T_S, MT = MP + MS;
constexpr int INW = 3072, FF = 4096, HW = 512;
constexpr int KVS = 1088;
constexpr int KVROWS = MP + NB_S * KVS;
constexpr int NMOD = NB_P + NB_S;
constexpr float EPS = 1e-5f;
constexpr float LOG2E = 1.4426950408889634f;
constexpr float QSCALE = 0.125f * LOG2E;
constexpr size_t O_YP = 0, O_YS = (size_t)MP * DM, O_KP = O_YS + (size_t)MS * DM, O_VP = O_KP + (size_t)MP * HW, O_CP = O_VP + (size_t)MP * HW,
                 O_KS = O_CP + (size_t)NB_P * 2 * HW, O_VS = O_KS + (size_t)MS * HW, O_CS = O_VS + (size_t)MS * HW, O_END = O_CS + (size_t)NB_S * 2 * HW;

namespace pg8 {
#define PG8_LAS __attribute__((address_space(3)))
typedef unsigned short bf16_t;
typedef short bf16x8 __attribute__((ext_vector_type(8)));
typedef float f32x4 __attribute__((ext_vector_type(4)));
typedef unsigned u32x4 __attribute__((ext_vector_type(4)));
constexpr int BM = 256, BK = 64, HALF = 128, HTB = HALF * BK * 2  , STAGE_BYTES = 8 * HTB, NXCD = 8, WGM = 8;

__host__ __device__ __forceinline__ int lds_byte(int r, int c) { const int st = (r >> 4) * 2 + (c >> 5), rr = r & 15, cc = c & 31, ob = rr * 64 + cc * 2; return st * 1024 + (ob ^ (((ob >> 9) & 1) << 5)); }
__host__ __device__ __forceinline__ void stage_rc(int b, int& R, int& C) { const int st = b / 1024, sb = b % 1024, swz = sb ^ (((sb >> 9) & 1) << 5); R = (st >> 1) * 16 + swz / 64; C = (st & 1) * 32 + (swz % 64) / 2; }
__host__ __device__ __forceinline__ int perm32(int rho) { const int n = rho >> 4, i = rho & 15; return 8 * (i >> 2) + 4 * n + (i & 3); }

struct Unit { int pm, pn, k0; };
struct Gemm { const bf16_t* A; const bf16_t* Bt; int M, N, K, Kext; };

struct StaticOrder {
    int nM, nN, nwg, G, c, rot;
    __host__ __device__ void init(int M, int N, int G_, int c_, int rot_ = 0) { nM = M / BM; nN = N / BM; nwg = nM * nN; G = G_; c = c_; rot = rot_; }
    __host__ __device__ bool next(int i, Unit& u) const {
        const long L = (long)i * G + c; if (L >= nwg) return false;
        int wgid = (int)L; { const int q = nwg / NXCD, r = nwg % NXCD, xcd = wgid % NXCD, off = wgid / NXCD; wgid = (xcd < r ? xcd * (q + 1) : r * (q + 1) + (xcd - r) * q) + off; }
        const int nig = WGM * nN, gid = wgid / nig, fm = gid * WGM, gsz = (nM - fm) < WGM ? (nM - fm) : WGM;
        u.pm = fm + ((wgid % nig) % gsz); u.pn = ((wgid % nig) / gsz + (rot ? ((gid >> 2) * 3) % nN : 0)) % nN; u.k0 = 0; return true;
    }
    __device__ __forceinline__ void a_ready(const Unit&) const {}
    __device__ __forceinline__ void done(const Unit&) const {}
};

struct SplitOrder {
    int nM, nN, nS, ksz, G, c;
    __host__ __device__ bool next(int i, Unit& u) const { const int L = i * G + c; if (L >= nM * nN * nS) return false; u.pm = L % nM; u.pn = (L / nM) % nN; u.k0 = (L / (nM * nN)) * ksz; return true; }
    __device__ __forceinline__ void a_ready(const Unit&) const {}
    __device__ __forceinline__ void done(const Unit&) const {}
};

__device__ __forceinline__ unsigned cvt_pk_bf16(float lo, float hi) { unsigned r; asm volatile("v_cvt_pk_bf16_f32 %0, %1, %2" : "=v"(r) : "v"(lo), "v"(hi)); return r; }
__device__ __forceinline__ u32x4 pack8(f32x4 v0, f32x4 v1) { u32x4 w; w.x = cvt_pk_bf16(v0[0], v0[1]); w.y = cvt_pk_bf16(v0[2], v0[3]); w.z = cvt_pk_bf16(v1[0], v1[1]); w.w = cvt_pk_bf16(v1[2], v1[3]); return w; }

__device__ __forceinline__ float fq_sum(float v) {
    auto a = __builtin_amdgcn_permlane16_swap(__float_as_uint(v), __float_as_uint(v), false, false); v = __uint_as_float(a[0]) + __uint_as_float(a[1]);
    auto b = __builtin_amdgcn_permlane32_swap(__float_as_uint(v), __float_as_uint(v), false, false); return __uint_as_float(b[0]) + __uint_as_float(b[1]); }
struct EpiIn {
    static constexpr bool PERM = true, AFTER_DRAIN = false;
    bf16_t *BG, *CG, *UG, *QB, *KB, *VB; float* out; unsigned* maxbuf;
    __device__ __forceinline__ void operator()(const f32x4 (&acc)[2][2][4][2], const Unit& u, int wr, int wc, int fr, int fq) const {
        const int seg = u.pn >> 1, col0 = (u.pn & 1) * 256 + wc * 32 + 8 * fq, row0 = u.pm * BM + wr * 64 + fr;
        const bool smp = u.pm >= (MP / BM);
        if (!smp && (seg == 3 || seg == 4)) {
            const float sc2 = seg == 3 ? QSCALE * QSCALE : 1.f; float mx[2] = {0.f, 0.f};
#pragma unroll
            for (int ai = 0; ai < 2; ++ai)
#pragma unroll
                for (int m = 0; m < 4; ++m)
#pragma unroll
                    for (int bj = 0; bj < 2; ++bj) { const f32x4 v0 = acc[ai][bj][m][0], v1 = acc[ai][bj][m][1];
                        float ss = (v0[0] * v0[0] + v0[1] * v0[1]) + (v0[2] * v0[2] + v0[3] * v0[3]) + (v1[0] * v1[0] + v1[1] * v1[1]) + (v1[2] * v1[2] + v1[3] * v1[3]);
                        ss = fq_sum(ss); mx[bj] = fmaxf(mx[bj], ss * sc2); }
#pragma unroll
            for (int bj = 0; bj < 2; ++bj)
                if (fq == 0) atomicMax(maxbuf + (seg == 4 ? 128 : 0) + (u.pm >> 5) * 16 + (u.pn & 1) * 8 + bj * 4 + wc, __float_as_uint(mx[bj]));
        }
        if (seg < 4) {
            bf16_t* base = seg == 0 ? BG : seg == 1 ? CG : seg == 2 ? UG : QB; const float sc = seg == 3 ? QSCALE : 1.f;
#pragma unroll
            for (int ai = 0; ai < 2; ++ai)
#pragma unroll
                for (int m = 0; m < 4; ++m) { bf16_t* rowp = base + (size_t)(row0 + ai * HALF + m * 16) * HW + col0;
#pragma unroll
                    for (int bj = 0; bj < 2; ++bj) *(u32x4*)(rowp + bj * HALF) = pack8(acc[ai][bj][m][0] * sc, acc[ai][bj][m][1] * sc); }
        } else {
            bf16_t* kvb = seg == 4 ? KB : VB;
            float* ob = out + (smp ? (seg == 4 ? O_KS : O_VS) : (seg == 4 ? O_KP : O_VP));
#pragma unroll
            for (int ai = 0; ai < 2; ++ai)
#pragma unroll
                for (int m = 0; m < 4; ++m) { const int row = row0 + ai * HALF + m * 16; const int rs = row - MP;
                    const size_t orow = smp ? (size_t)rs : (size_t)row;
                    const size_t kvrow = smp ? (size_t)(MP + (rs >> 5) * KVS + PAST + (rs & 31)) : (size_t)row;
                    float* op = ob + orow * HW + col0; bf16_t* kp = kvb + kvrow * HW + col0;
#pragma unroll
                    for (int bj = 0; bj < 2; ++bj) { const f32x4 v0 = acc[ai][bj][m][0], v1 = acc[ai][bj][m][1];
                        __builtin_nontemporal_store(v0, (f32x4*)(op + bj * HALF)); __builtin_nontemporal_store(v1, (f32x4*)(op + bj * HALF + 4)); *(u32x4*)(kp + bj * HALF) = pack8(v0, v1); } }
        }
    }
};
struct EpiResGate {
    static constexpr bool PERM = true, AFTER_DRAIN = false;
    const float* res_p; const float* res_s; float* out; const float* gate;
    __device__ __forceinline__ void operator()(const f32x4 (&acc)[2][2][4][2], const Unit& u, int wr, int wc, int fr, int fq) const {
        const int col0 = u.pn * BM + wc * 32 + 8 * fq, row0 = u.pm * BM + wr * 64 + fr;
#pragma unroll
        for (int ai = 0; ai < 2; ++ai)
#pragma unroll
            for (int m = 0; m < 4; ++m) { const int row = row0 + ai * HALF + m * 16;
                const int mrow = row < MP ? (row >> 13) : NB_P + ((row - MP) >> 5);
                const float* rp = (row < MP ? res_p + (size_t)row * DM : res_s + (size_t)(row - MP) * DM) + col0;
                const float* gp = gate + (size_t)mrow * (6 * DM) + col0; float* op = out + (size_t)row * DM + col0;
#pragma unroll
                for (int bj = 0; bj < 2; ++bj) {
                    const f32x4 g0 = *(const f32x4*)(gp + bj * HALF), g1 = *(const f32x4*)(gp + bj * HALF + 4);
                    const f32x4 x0 = *(const f32x4*)(rp + bj * HALF), x1 = *(const f32x4*)(rp + bj * HALF + 4);
                    *(f32x4*)(op + bj * HALF) = x0 + g0 * acc[ai][bj][m][0]; *(f32x4*)(op + bj * HALF + 4) = x1 + g1 * acc[ai][bj][m][1]; }
                if (m & 1) asm volatile("" ::: "memory"); }
    }
};
struct EpiRelu2 {
    static constexpr bool PERM = true, AFTER_DRAIN = false;
    bf16_t* O; int ldc;
    __device__ __forceinline__ void operator()(const f32x4 (&acc)[2][2][4][2], const Unit& u, int wr, int wc, int fr, int fq) const {
        const int col0 = u.pn * BM + wc * 32 + 8 * fq, row0 = u.pm * BM + wr * 64 + fr;
#pragma unroll
        for (int ai = 0; ai < 2; ++ai)
#pragma unroll
            for (int m = 0; m < 4; ++m) { bf16_t* rowp = O + (size_t)(row0 + ai * HALF + m * 16) * ldc + col0;
#pragma unroll
                for (int bj = 0; bj < 2; ++bj) { f32x4 v0 = acc[ai][bj][m][0], v1 = acc[ai][bj][m][1];
#pragma unroll
                    for (int e = 0; e < 4; ++e) { const float a = fmaxf(v0[e], 0.f), b = fmaxf(v1[e], 0.f); v0[e] = a * a; v1[e] = b * b; }
                    *(u32x4*)(rowp + bj * HALF) = pack8(v0, v1); } }
    }
};

struct EpiResGate2 {
    static constexpr bool PERM = true, AFTER_DRAIN = false;
    const float* res_p; const float* res_s; float* out; const float* gate; const float* sc2; const float* n2g; bf16_t* XN; float* rowss;
    __device__ __forceinline__ void operator()(const f32x4 (&acc)[2][2][4][2], const Unit& u, int wr, int wc, int fr, int fq) const {
        const int col0 = u.pn * BM + wc * 32 + 8 * fq, row0 = u.pm * BM + wr * 64 + fr;
#pragma unroll
        for (int ai = 0; ai < 2; ++ai)
#pragma unroll
            for (int m = 0; m < 4; ++m) { const int row = row0 + ai * HALF + m * 16;
                const int mrow = row < MP ? (row >> 13) : NB_P + ((row - MP) >> 5);
                const float* rp = (row < MP ? res_p + (size_t)row * DM : res_s + (size_t)(row - MP) * DM) + col0;
                const float* gp = gate + (size_t)mrow * (6 * DM) + col0; const float* cp = sc2 + (size_t)mrow * (6 * DM) + col0; float* op = out + (size_t)row * DM + col0;
                bf16_t* xp = XN + (size_t)row * DM + col0; float ss = 0.f;
#pragma unroll
                for (int bj = 0; bj < 2; ++bj) {
                    const f32x4 g0 = *(const f32x4*)(gp + bj * HALF), g1 = *(const f32x4*)(gp + bj * HALF + 4);
                    const f32x4 x0 = *(const f32x4*)(rp + bj * HALF), x1 = *(const f32x4*)(rp + bj * HALF + 4);
                    const f32x4 y0 = x0 + g0 * acc[ai][bj][m][0], y1 = x1 + g1 * acc[ai][bj][m][1];
                    *(f32x4*)(op + bj * HALF) = y0; *(f32x4*)(op + bj * HALF + 4) = y1;
                    ss += (y0[0] * y0[0] + y0[1] * y0[1]) + (y0[2] * y0[2] + y0[3] * y0[3]) + (y1[0] * y1[0] + y1[1] * y1[1]) + (y1[2] * y1[2] + y1[3] * y1[3]);
                    const f32x4 n0 = *(const f32x4*)(n2g + col0 + bj * HALF), n1 = *(const f32x4*)(n2g + col0 + bj * HALF + 4);
                    const f32x4 c0 = *(const f32x4*)(cp + bj * HALF), c1 = *(const f32x4*)(cp + bj * HALF + 4);
                    *(u32x4*)(xp + bj * HALF) = pack8(y0 * n0 * (c0 + 1.f), y1 * n1 * (c1 + 1.f)); }
                ss = fq_sum(ss);
                if (fq == 0) unsafeAtomicAdd(rowss + row, ss);
                asm volatile("" ::: "memory"); }
    }
};
struct EpiRelu2N {
    static constexpr bool PERM = true, AFTER_DRAIN = false;
    bf16_t* O; int ldc; const float* rowss; const float* bias2;
    __device__ __forceinline__ void operator()(const f32x4 (&acc)[2][2][4][2], const Unit& u, int wr, int wc, int fr, int fq) const {
        const int col0 = u.pn * BM + wc * 32 + 8 * fq, row0 = u.pm * BM + wr * 64 + fr;
#pragma unroll
        for (int ai = 0; ai < 2; ++ai)
#pragma unroll
            for (int m = 0; m < 4; ++m) { const int row = row0 + ai * HALF + m * 16; const int mrow = row < MP ? (row >> 13) : NB_P + ((row - MP) >> 5);
                const float rstd = 1.f / sqrtf(rowss[row] * (1.f / DM) + EPS);
                const float* bp = bias2 + (size_t)mrow * FF + col0; bf16_t* rowp = O + (size_t)row * ldc + col0;
#pragma unroll
                for (int bj = 0; bj < 2; ++bj) { f32x4 v0 = acc[ai][bj][m][0] * rstd + *(const f32x4*)(bp + bj * HALF), v1 = acc[ai][bj][m][1] * rstd + *(const f32x4*)(bp + bj * HALF + 4);
#pragma unroll
                    for (int e = 0; e < 4; ++e) { const float a = fmaxf(v0[e], 0.f), b = fmaxf(v1[e], 0.f); v0[e] = a * a; v1[e] = b * b; }
                    *(u32x4*)(rowp + bj * HALF) = pack8(v0, v1); } }
    }
};
struct EpiPartial {
    static constexpr bool PERM = true, AFTER_DRAIN = false;
    float* part; int ksz, nrows, ld;
    __device__ __forceinline__ void operator()(const f32x4 (&acc)[2][2][4][2], const Unit& u, int wr, int wc, int fr, int fq) const {
        const int col0 = u.pn * BM + wc * 32 + 8 * fq, row0 = u.pm * BM + wr * 64 + fr;
        float* pb = part + (size_t)(u.k0 / ksz) * nrows * ld;
#pragma unroll
        for (int ai = 0; ai < 2; ++ai)
#pragma unroll
            for (int m = 0; m < 4; ++m) { float* op = pb + (size_t)(row0 + ai * HALF + m * 16) * ld + col0;
#pragma unroll
                for (int bj = 0; bj < 2; ++bj) { *(f32x4*)(op + bj * HALF) = acc[ai][bj][m][0]; *(f32x4*)(op + bj * HALF + 4) = acc[ai][bj][m][1]; } }
    }
};

template <class Epi, class Sched, bool ALIGN_EPI = false, bool SP2 = false>
__device__ __forceinline__ void gemm_phase(PG8_LAS unsigned char* lds, const Gemm g, const Sched& S, const Epi& E) {
    int tid = threadIdx.x; asm volatile("" : "+v"(tid));
    const int wid = __builtin_amdgcn_readfirstlane(tid >> 6), lane = tid & 63, wr = wid >> 2, wc = wid & 3, fr = lane & 15, fq = lane >> 4;
    const int K = g.K, nt = (g.Kext ? g.Kext : K) / BK;
    unsigned voffA[2], voffB[2];
#pragma unroll
    for (int i = 0; i < 2; ++i) { int R, C; stage_rc(tid * 16 + i * 8192, R, C); const int Rb = Epi::PERM ? ((R & ~31) + perm32(R & 31)) : R;
        voffA[i] = (unsigned)(R * K + C) * 2u; voffB[i] = (unsigned)(Rb * K + C) * 2u; }
    const size_t kstep = (size_t)(BK * 2);
    const size_t hstep = (size_t)HALF * K * 2;
    const size_t tstep = 2 * hstep;
    const unsigned ldsw = (unsigned)wid * 1024u;
    const int aoff = lds_byte(wr * 64 + fr, fq * 8), boff = lds_byte(wc * 32 + fr, fq * 8);
#define PG8_SA(b, h) (((b) * 2 + (h)) * HTB)
#define PG8_SB(b, h) ((4 + (b) * 2 + (h)) * HTB)
#define PG8_STAGE(bufoff, gbase, voff) do { _Pragma("unroll") for (int _i = 0; _i < 2; ++_i) \
        __builtin_amdgcn_global_load_lds((const unsigned*)((const char*)(gbase) + (voff)[_i]), (PG8_LAS unsigned*)(lds + (bufoff) + ldsw + _i * 8192), 16, 0, 0); } while (0)
#define PG8_LDA(dst, b, h) do { _Pragma("unroll") for (int m = 0; m < 4; ++m) _Pragma("unroll") for (int k = 0; k < 2; ++k) dst[m][k] = *(const PG8_LAS bf16x8*)(lds + PG8_SA(b, h) + aoff + m * 2048 + k * 1024); } while (0)
#define PG8_LDB(dst, b, h) do { _Pragma("unroll") for (int n = 0; n < 2; ++n) _Pragma("unroll") for (int k = 0; k < 2; ++k) dst[n][k] = *(const PG8_LAS bf16x8*)(lds + PG8_SB(b, h) + boff + n * 2048 + k * 1024); } while (0)
#define PG8_MMA(ai, bj, At, Bt) do { __builtin_amdgcn_s_setprio(1); _Pragma("unroll") for (int m = 0; m < 4; ++m) _Pragma("unroll") for (int n = 0; n < 2; ++n) _Pragma("unroll") for (int k = 0; k < 2; ++k) \
        acc[ai][bj][m][n] = __builtin_amdgcn_mfma_f32_16x16x32_bf16(Bt[n][k], At[m][k], acc[ai][bj][m][n], 0, 0, 0); __builtin_amdgcn_s_setprio(0); } while (0)
#define PG8_WAIT_V(n) asm volatile("s_waitcnt vmcnt(" #n ")" ::: "memory")
#define PG8_WAIT_L(n) asm volatile("s_waitcnt lgkmcnt(" #n ")" ::: "memory")
#define PG8_BAR __builtin_amdgcn_s_barrier()
#define PG8_SCHED __builtin_amdgcn_sched_barrier(0)
    Unit cur, nxt; int ui = 0;
    if (!S.next(0, cur)) return;
    f32x4 acc[2][2][4][2];
#pragma unroll
    for (int a = 0; a < 2; ++a)
#pragma unroll
        for (int b = 0; b < 2; ++b)
#pragma unroll
            for (int m = 0; m < 4; ++m)
#pragma unroll
                for (int n = 0; n < 2; ++n) acc[a][b][m][n] = (f32x4){0.f, 0.f, 0.f, 0.f};
    bf16x8 At[4][2], B0[2][2], B1[2][2];
    const char* cA = (const char*)g.A + (size_t)cur.pm * tstep + (size_t)cur.k0 * 2; const char* cB = (const char*)g.Bt + (size_t)cur.pn * tstep + (size_t)cur.k0 * 2;
    S.a_ready(cur);
    if constexpr (SP2) {
        PG8_STAGE(PG8_SB(0, 0), cB, voffB); PG8_STAGE(PG8_SB(0, 1), cB + hstep, voffB); PG8_STAGE(PG8_SA(0, 0), cA, voffA); PG8_STAGE(PG8_SA(0, 1), cA + hstep, voffA);
        if (wr == 1) PG8_BAR;
        PG8_WAIT_V(2); PG8_BAR;
        PG8_STAGE(PG8_SB(1, 0), cB + kstep, voffB); PG8_STAGE(PG8_SA(1, 0), cA + kstep, voffA); PG8_STAGE(PG8_SB(1, 1), cB + hstep + kstep, voffB);
        PG8_WAIT_V(6); PG8_BAR;
    } else {
        PG8_STAGE(PG8_SB(0, 0), cB, voffB); PG8_STAGE(PG8_SA(0, 0), cA, voffA); PG8_STAGE(PG8_SB(0, 1), cB + hstep, voffB); PG8_STAGE(PG8_SA(0, 1), cA + hstep, voffA);
        if (wr == 1) PG8_BAR;
        PG8_WAIT_V(4); PG8_BAR;
        PG8_STAGE(PG8_SB(1, 0), cB + kstep, voffB); PG8_STAGE(PG8_SA(1, 0), cA + kstep, voffA); PG8_STAGE(PG8_SB(1, 1), cB + hstep + kstep, voffB);
        PG8_WAIT_V(6); PG8_BAR;
    }
    for (;;) {
        const bool has_next = S.next(ui + 1, nxt);
        const char* nA = has_next ? (const char*)g.A + (size_t)nxt.pm * tstep + (size_t)nxt.k0 * 2 : cA; const char* nB = has_next ? (const char*)g.Bt + (size_t)nxt.pn * tstep + (size_t)nxt.k0 * 2 : cB;
        for (int t = 0; t < nt; t += 2) {
            const bool last = (t == nt - 2);
            const char* a1 = cA + (size_t)(t + 1) * kstep;
            const char* a2 = last ? nA : cA + (size_t)(t + 2) * kstep; const char* b2 = last ? nB : cB + (size_t)(t + 2) * kstep;
            const char* a3 = a2 + kstep; const char* b3 = b2 + kstep;
            if (last && has_next) S.a_ready(nxt);
            if constexpr (SP2) {
            PG8_LDB(B0, 0, 0); PG8_LDB(B1, 0, 1); PG8_SCHED; PG8_LDA(At, 0, 0); PG8_STAGE(PG8_SA(1, 1), a1 + hstep, voffA);
            PG8_WAIT_V(8); PG8_WAIT_L(0); PG8_BAR; PG8_MMA(0, 0, At, B0); PG8_MMA(0, 1, At, B1); PG8_BAR; PG8_SCHED;
            PG8_LDA(At, 0, 1); PG8_STAGE(PG8_SB(0, 0), b2, voffB); PG8_STAGE(PG8_SB(0, 1), b2 + hstep, voffB); PG8_STAGE(PG8_SA(0, 0), a2, voffA);
            PG8_WAIT_V(8); PG8_WAIT_L(0); PG8_BAR; PG8_MMA(1, 0, At, B0); PG8_MMA(1, 1, At, B1); PG8_BAR; PG8_SCHED;
            PG8_LDB(B0, 1, 0); PG8_LDB(B1, 1, 1); PG8_SCHED; PG8_LDA(At, 1, 0); PG8_STAGE(PG8_SA(0, 1), a2 + hstep, voffA);
            PG8_WAIT_V(8); PG8_WAIT_L(0); PG8_BAR; PG8_MMA(0, 0, At, B0); PG8_MMA(0, 1, At, B1); PG8_BAR; PG8_SCHED;
            PG8_LDA(At, 1, 1); PG8_STAGE(PG8_SB(1, 0), b3, voffB); PG8_STAGE(PG8_SB(1, 1), b3 + hstep, voffB); PG8_STAGE(PG8_SA(1, 0), a3, voffA);
            PG8_WAIT_V(8); PG8_WAIT_L(0); PG8_BAR; PG8_MMA(1, 0, At, B0); PG8_MMA(1, 1, At, B1); PG8_BAR; PG8_SCHED;
            } else {
            PG8_LDB(B0, 0, 0); PG8_SCHED; PG8_LDA(At, 0, 0); PG8_STAGE(PG8_SA(1, 1), a1 + hstep, voffA);
            PG8_WAIT_L(8); PG8_BAR; PG8_WAIT_L(0); PG8_MMA(0, 0, At, B0); PG8_BAR; PG8_SCHED;
            PG8_LDB(B1, 0, 1); PG8_STAGE(PG8_SB(0, 0), b2, voffB);
            PG8_BAR; PG8_WAIT_L(0); PG8_MMA(0, 1, At, B1); PG8_BAR;
            PG8_LDA(At, 0, 1); PG8_STAGE(PG8_SA(0, 0), a2, voffA);
            PG8_BAR; PG8_WAIT_L(0); PG8_MMA(1, 0, At, B0); PG8_BAR; PG8_SCHED;
            PG8_STAGE(PG8_SB(0, 1), b2 + hstep, voffB);
            PG8_WAIT_V(6); PG8_BAR; PG8_MMA(1, 1, At, B1); PG8_BAR;
            PG8_LDB(B0, 1, 0); PG8_SCHED; PG8_LDA(At, 1, 0); PG8_STAGE(PG8_SA(0, 1), a2 + hstep, voffA);
            PG8_WAIT_L(8); PG8_BAR; PG8_WAIT_L(0); PG8_MMA(0, 0, At, B0); PG8_BAR; PG8_SCHED;
            PG8_LDB(B1, 1, 1); PG8_STAGE(PG8_SB(1, 0), b3, voffB);
            PG8_BAR; PG8_WAIT_L(0); PG8_MMA(0, 1, At, B1); PG8_BAR;
            PG8_LDA(At, 1, 1); PG8_STAGE(PG8_SA(1, 0), a3, voffA);
            PG8_BAR; PG8_WAIT_L(0); PG8_MMA(1, 0, At, B0); PG8_BAR; PG8_SCHED;
            PG8_STAGE(PG8_SB(1, 1), b3 + hstep, voffB);
            PG8_WAIT_V(6); PG8_BAR; PG8_MMA(1, 1, At, B1); PG8_BAR;
            }
        }
        if constexpr (ALIGN_EPI) { if (wr == 0) PG8_BAR; }
        if constexpr (!Epi::AFTER_DRAIN) { E(acc, cur, wr, wc, fr, fq); S.done(cur); }
        if (!has_next) break;
#pragma unroll
        for (int a = 0; a < 2; ++a)
#pragma unroll
            for (int b = 0; b < 2; ++b)
#pragma unroll
                for (int m = 0; m < 4; ++m)
#pragma unroll
                    for (int n = 0; n < 2; ++n) acc[a][b][m][n] = (f32x4){0.f, 0.f, 0.f, 0.f};
        cur = nxt; cA = nA; cB = nB; ++ui;
        if constexpr (ALIGN_EPI) { if (wr == 1) PG8_BAR; }
    }
    PG8_WAIT_V(0);
    if constexpr (!ALIGN_EPI) { if (wr == 0) PG8_BAR; }
    PG8_BAR;
    if constexpr (Epi::AFTER_DRAIN) { E.fused(acc, cur, wr, wc, fr, fq, lds, wid, lane); S.done(cur); }
#undef PG8_SA
#undef PG8_SB
#undef PG8_STAGE
#undef PG8_LDA
#undef PG8_LDB
#undef PG8_MMA
#undef PG8_WAIT_V
#undef PG8_WAIT_L
#undef PG8_BAR
#undef PG8_SCHED
}
}

namespace att {
#define ALAS __attribute__((address_space(3)))
typedef unsigned short bf16_t;
typedef short bf16x8 __attribute__((ext_vector_type(8)));
typedef short s16x4 __attribute__((ext_vector_type(4)));
typedef float f32x16 __attribute__((ext_vector_type(16)));
typedef float f32x4 __attribute__((ext_vector_type(4)));
typedef float f32x2_t __attribute__((ext_vector_type(2)));
typedef __bf16 bf16x2_t __attribute__((ext_vector_type(2)));
typedef unsigned u32x4 __attribute__((ext_vector_type(4)));
typedef unsigned u32x2 __attribute__((ext_vector_type(2)));
typedef short v4i16_t __attribute__((ext_vector_type(4)));
constexpr int TILE_B = 16384;
constexpr int STG_K = 0, STG_V = 2 * TILE_B, STG_B = 4 * TILE_B;
__device__ __forceinline__ int crow(int r, int h) { return (r & 3) + 8 * (r >> 2) + 4 * h; }
__device__ __forceinline__ unsigned cvtpk(float lo, float hi) { f32x2_t v = {lo, hi}; bf16x2_t b = __builtin_convertvector(v, bf16x2_t); return __builtin_bit_cast(unsigned, b); }
__device__ __forceinline__ float half_max(float v) { auto rr = __builtin_amdgcn_permlane32_swap(__float_as_uint(v), __float_as_uint(v), false, false); return fmaxf(__uint_as_float(rr[0]), __uint_as_float(rr[1])); }
__device__ __forceinline__ float half_sum(float v) { auto rr = __builtin_amdgcn_permlane32_swap(__float_as_uint(v), __float_as_uint(v), false, false); return __uint_as_float(rr[0]) + __uint_as_float(rr[1]); }
__device__ __forceinline__ s16x4 vtr(const ALAS unsigned char* p) { return __builtin_bit_cast(s16x4, __builtin_amdgcn_ds_read_tr16_b64_v4i16((ALAS v4i16_t*)p)); }

struct UnitDesc { const bf16_t* Q; const bf16_t* K; const bf16_t* V; bf16_t* O; int q0pos, nvalid, kv_len, s_hi, s_lo; float slope2; };

__device__ __forceinline__ void attn_unit(ALAS unsigned char* lds, const UnitDesc d, const float lam, const float* __restrict__ subg) {
    int tid = threadIdx.x; asm volatile("" : "+v"(tid));
    const int lane = tid & 63, w = __builtin_amdgcn_readfirstlane(tid >> 6), c = w >> 2, j = w & 3, r32 = lane & 31, hh = lane >> 5;
    const bool active = (32 * j < d.nvalid);
    const int qw0 = d.q0pos + 32 * j;
    const int td = active ? (qw0 >> 6) : -1;
    const int lrow = lane >> 4; const unsigned fsw = (((unsigned)lrow & 3u) << 2) | ((unsigned)w & 3u); const int gch = (int)(((unsigned)lane & 15u) ^ fsw);
    const bf16_t* kg = d.K + (size_t)(4 * w + lrow) * HW + gch * 8;
    const bf16_t* vg = d.V + (size_t)(4 * w + lrow) * HW + gch * 8;
#define ATT_DMA(s_, buf_) do { const size_t go_ = (size_t)(s_) * 128 * HW; ALAS unsigned char* lb_ = lds + (buf_) * STG_B + w * 1024; \
        _Pragma("unroll") for (int i_ = 0; i_ < 4; ++i_) { \
        __builtin_amdgcn_global_load_lds((const unsigned*)(kg + go_ + (size_t)i_ * 32 * HW), (ALAS unsigned*)(lb_ + STG_K + i_ * 8192), 16, 0, 0); \
        __builtin_amdgcn_global_load_lds((const unsigned*)(vg + go_ + (size_t)i_ * 32 * HW), (ALAS unsigned*)(lb_ + STG_V + i_ * 8192), 16, 0, 0); } } while (0)
    bf16x8 qf[4];
#pragma unroll
    for (int s = 0; s < 4; ++s) { if (active) qf[s] = *(const bf16x8*)(d.Q + (size_t)(32 * j + r32) * HW + c * 64 + 16 * s + 8 * hh); else qf[s] = (bf16x8){0, 0, 0, 0, 0, 0, 0, 0}; }
    unsigned koff[4];
    { const unsigned f = ((r32 & 3u) << 2) | ((r32 >> 2) & 3u);
#pragma unroll
      for (int s = 0; s < 4; ++s) koff[s] = 256u * r32 + 16u * (((unsigned)(8 * c + 2 * s + hh)) ^ f); }
    unsigned voff[2][4];
    { const unsigned qq = (lane & 15) >> 2, p = lane & 3, blk = (lane >> 4) & 1;
#pragma unroll
      for (int tt = 0; tt < 2; ++tt)
#pragma unroll
          for (int c4 = 0; c4 < 4; ++c4)
              voff[tt][c4] = 256u * (8 * tt + 4 * hh + qq) + 16u * ((((unsigned)c4 ^ qq) << 2) | (((2 * blk + (p >> 1)) ^ (unsigned)(2 * tt + hh)) & 3u)) + 8u * (p & 1); }
    float mref = 0.f, lsum = 0.f;
    f32x16 o[4];
#pragma unroll
    for (int c4 = 0; c4 < 4; ++c4)
#pragma unroll
        for (int i = 0; i < 16; ++i) o[c4][i] = 0.f;

    const int NI = d.s_hi - d.s_lo + 1;
    ATT_DMA(d.s_lo, 0);
    for (int it = 0; it + 1 < NI; ++it) {
        const int sg = d.s_lo + it;
        asm volatile("s_waitcnt vmcnt(0)" ::: "memory"); __syncthreads();
        ATT_DMA(sg + 1, (it + 1) & 1);
        const ALAS unsigned char* Sb = lds + (it & 1) * STG_B;
#define ATT_SB() __builtin_amdgcn_sched_barrier(0)
#define ATT_KLD(Kb_) do { _Pragma("unroll") for (int s = 0; s < 4; ++s) { kf[2 * s] = *(const ALAS bf16x8*)((Kb_) + koff[s]); kf[2 * s + 1] = *(const ALAS bf16x8*)((Kb_) + koff[s] + 8192); } } while (0)
#define ATT_QK(x0_, x1_) do { _Pragma("unroll") for (int s = 0; s < 4; ++s) { x0_ = __builtin_amdgcn_mfma_f32_32x32x16_bf16(kf[2 * s], qf[s], x0_, 0, 0, 0); x1_ = __builtin_amdgcn_mfma_f32_32x32x16_bf16(kf[2 * s + 1], qf[s], x1_, 0, 0, 0); } } while (0)
#define ATT_VLD2(bsel_, Vb_, ks_) do { _Pragma("unroll") for (int c4 = 0; c4 < 4; ++c4) { vl[bsel_][c4] = vtr((Vb_) + voff[0][c4] + 4096 * (ks_)); vh[bsel_][c4] = vtr((Vb_) + voff[1][c4] + 4096 * (ks_)); } } while (0)
#define ATT_PVK(ks_, pf_) do { _Pragma("unroll") for (int c4 = 0; c4 < 4; ++c4) { const s16x4 lo = vl[(ks_) & 1][c4], hi = vh[(ks_) & 1][c4]; \
            const bf16x8 vt = (bf16x8){lo[0], lo[1], lo[2], lo[3], hi[0], hi[1], hi[2], hi[3]}; o[c4] = __builtin_amdgcn_mfma_f32_32x32x16_bf16(vt, pf_[ks_], o[c4], 0, 0, 0); } } while (0)
#define ATT_SOFTMAX(x0_, x1_, pf_) do { float ps_ = 0.f; \
            _Pragma("unroll") for (int i = 0; i < 16; ++i) { x0_[i] = __builtin_amdgcn_exp2f(x0_[i]); x1_[i] = __builtin_amdgcn_exp2f(x1_[i]); } \
            _Pragma("unroll") for (int i = 0; i < 16; i += 2) pm = fmaxf(fmaxf(pm, fmaxf(x0_[i], x0_[i + 1])), fmaxf(x1_[i], x1_[i + 1])); \
            _Pragma("unroll") for (int i = 0; i < 16; ++i) ps_ += x0_[i] + x1_[i]; \
            lsum += ps_; \
            _Pragma("unroll") for (int s = 0; s < 2; ++s) { u32x4 a_, b_; \
                a_.x = cvtpk(x0_[8 * s], x0_[8 * s + 1]); a_.y = cvtpk(x0_[8 * s + 2], x0_[8 * s + 3]); a_.z = cvtpk(x0_[8 * s + 4], x0_[8 * s + 5]); a_.w = cvtpk(x0_[8 * s + 6], x0_[8 * s + 7]); \
                b_.x = cvtpk(x1_[8 * s], x1_[8 * s + 1]); b_.y = cvtpk(x1_[8 * s + 2], x1_[8 * s + 3]); b_.z = cvtpk(x1_[8 * s + 4], x1_[8 * s + 5]); b_.w = cvtpk(x1_[8 * s + 6], x1_[8 * s + 7]); \
                pf_[s] = __builtin_bit_cast(bf16x8, a_); pf_[2 + s] = __builtin_bit_cast(bf16x8, b_); } } while (0)
        if (active) {
            const ALAS unsigned char* K0 = Sb + STG_K; const ALAS unsigned char* V0 = Sb + STG_V;
            f32x16 a0, a1, b0, b1;
            { const float c0 = d.slope2 * (float)(128 * sg - qw0 + 4 * hh) - mref, st = 32.f * d.slope2;
#pragma unroll
              for (int i = 0; i < 16; ++i) { const float ci = (float)((i & 3) + 8 * (i >> 2));
                  a0[i] = __builtin_fmaf(d.slope2, ci, c0); a1[i] = __builtin_fmaf(d.slope2, ci, c0 + st); b0[i] = __builtin_fmaf(d.slope2, ci, c0 + 2.f * st); b1[i] = __builtin_fmaf(d.slope2, ci, c0 + 3.f * st); } }
            bf16x8 kf[8]; s16x4 vl[2][4], vh[2][4]; bf16x8 pfA[4], pfB[4]; float pm = 0.f;
            ATT_KLD(K0); ATT_SB();
            ATT_QK(a0, a1);
            ATT_KLD(K0 + TILE_B); ATT_SB();
            ATT_QK(b0, b1);
            ATT_SOFTMAX(a0, a1, pfA);
#pragma unroll
            for (int g = 0; g < 8; ++g) { __builtin_amdgcn_sched_group_barrier(0x008, 1, 0); __builtin_amdgcn_sched_group_barrier(0x400, 4, 0); __builtin_amdgcn_sched_group_barrier(0x002, 9, 0); }
            ATT_SB();
            ATT_VLD2(0, V0, 0); ATT_VLD2(1, V0, 1); ATT_SB();
            float psB = 0.f;
#define ATT_SM_CHUNK(k_) do { _Pragma("unroll") for (int i = 4 * (k_); i < 4 * (k_) + 4; ++i) { b0[i] = __builtin_amdgcn_exp2f(b0[i]); b1[i] = __builtin_amdgcn_exp2f(b1[i]); } \
            pm = fmaxf(fmaxf(pm, fmaxf(b0[4 * (k_)], b0[4 * (k_) + 1])), fmaxf(b0[4 * (k_) + 2], b0[4 * (k_) + 3])); pm = fmaxf(fmaxf(pm, fmaxf(b1[4 * (k_)], b1[4 * (k_) + 1])), fmaxf(b1[4 * (k_) + 2], b1[4 * (k_) + 3])); \
            psB += (b0[4 * (k_)] + b0[4 * (k_) + 1]) + (b0[4 * (k_) + 2] + b0[4 * (k_) + 3]) + (b1[4 * (k_)] + b1[4 * (k_) + 1]) + (b1[4 * (k_) + 2] + b1[4 * (k_) + 3]); } while (0)
#define ATT_PIPE4() do { _Pragma("unroll") for (int g = 0; g < 4; ++g) { __builtin_amdgcn_sched_group_barrier(0x008, 1, 2); __builtin_amdgcn_sched_group_barrier(0x400, 2, 2); __builtin_amdgcn_sched_group_barrier(0x002, 4, 2); } } while (0)
            ATT_PVK(0, pfA); ATT_SM_CHUNK(0); ATT_VLD2(0, V0, 2); ATT_PIPE4(); ATT_SB();
            ATT_PVK(1, pfA); ATT_SM_CHUNK(1); ATT_VLD2(1, V0, 3); ATT_PIPE4(); ATT_SB();
            ATT_PVK(2, pfA); ATT_SM_CHUNK(2); ATT_VLD2(0, V0 + TILE_B, 0); ATT_PIPE4(); ATT_SB();
            ATT_PVK(3, pfA); ATT_SM_CHUNK(3); ATT_VLD2(1, V0 + TILE_B, 1);
            lsum += psB;
#pragma unroll
            for (int s2 = 0; s2 < 2; ++s2) { u32x4 a_, b_;
                a_.x = cvtpk(b0[8 * s2], b0[8 * s2 + 1]); a_.y = cvtpk(b0[8 * s2 + 2], b0[8 * s2 + 3]); a_.z = cvtpk(b0[8 * s2 + 4], b0[8 * s2 + 5]); a_.w = cvtpk(b0[8 * s2 + 6], b0[8 * s2 + 7]);
                b_.x = cvtpk(b1[8 * s2], b1[8 * s2 + 1]); b_.y = cvtpk(b1[8 * s2 + 2], b1[8 * s2 + 3]); b_.z = cvtpk(b1[8 * s2 + 4], b1[8 * s2 + 5]); b_.w = cvtpk(b1[8 * s2 + 6], b1[8 * s2 + 7]);
                pfB[s2] = __builtin_bit_cast(bf16x8, a_); pfB[2 + s2] = __builtin_bit_cast(bf16x8, b_); }
#pragma unroll
            for (int g = 0; g < 4; ++g) { __builtin_amdgcn_sched_group_barrier(0x008, 1, 3); __builtin_amdgcn_sched_group_barrier(0x400, 2, 3); __builtin_amdgcn_sched_group_barrier(0x002, 8, 3); }
            ATT_SB();
            ATT_PVK(0, pfB); ATT_VLD2(0, V0 + TILE_B, 2); ATT_SB();
            ATT_PVK(1, pfB); ATT_VLD2(1, V0 + TILE_B, 3); ATT_SB();
            ATT_PVK(2, pfB);
            ATT_PVK(3, pfB);
            ATT_SB();
#undef ATT_SM_CHUNK
#undef ATT_PIPE4
            if (__builtin_expect(__any(pm > 256.f), 0)) {
                pm = half_max(pm);
                const float dl = pm > 1.f ? ceilf(__builtin_amdgcn_logf(pm)) : 0.f, f = __builtin_amdgcn_exp2f(-dl);
                mref += dl; lsum *= f;
#pragma unroll
                for (int c4 = 0; c4 < 4; ++c4)
#pragma unroll
                    for (int i = 0; i < 16; ++i) o[c4][i] *= f;
            }
        }
    }
    {
        const int it = NI - 1, sg = d.s_hi;
        asm volatile("s_waitcnt vmcnt(0)" ::: "memory"); __syncthreads();
        const ALAS unsigned char* Sb = lds + (it & 1) * STG_B;
#pragma unroll
        for (int tau = 0; tau < 2; ++tau) {
            const int t = 2 * sg + tau;
            if (t <= td) {
                const ALAS unsigned char* Kb = Sb + STG_K + tau * TILE_B; const ALAS unsigned char* Vb = Sb + STG_V + tau * TILE_B;
                f32x16 s0, s1;
                if (t == td) {
                    const int qpos = qw0 + r32; const float rc = d.slope2 * (float)r32 - mref;
#pragma unroll
                    for (int i = 0; i < 16; ++i) { const int k0 = 64 * t + crow(i, hh), k1 = k0 + 32;
                        const int d0 = qpos - k0, d1 = qpos - k1;
                        s0[i] = k0 < d.kv_len ? rc - d.slope2 * (float)(d0 < 0 ? -d0 : d0) : -1e30f;
                        s1[i] = k1 < d.kv_len ? rc - d.slope2 * (float)(d1 < 0 ? -d1 : d1) : -1e30f; }
                } else {
                    const float b0 = d.slope2 * (float)(64 * t - qw0 + 4 * hh) - mref, b1 = b0 + 32.f * d.slope2;
#pragma unroll
                    for (int i = 0; i < 16; ++i) { const float ci = (float)((i & 3) + 8 * (i >> 2)); s0[i] = __builtin_fmaf(d.slope2, ci, b0); s1[i] = __builtin_fmaf(d.slope2, ci, b1); }
                }
                bf16x8 kf[8];
#pragma unroll
                for (int s = 0; s < 4; ++s) { kf[2 * s] = *(const ALAS bf16x8*)(Kb + koff[s]); kf[2 * s + 1] = *(const ALAS bf16x8*)(Kb + koff[s] + 8192); }
                __builtin_amdgcn_sched_barrier(0);
#pragma unroll
                for (int s = 0; s < 4; ++s) {
                    s0 = __builtin_amdgcn_mfma_f32_32x32x16_bf16(kf[2 * s], qf[s], s0, 0, 0, 0);
                    s1 = __builtin_amdgcn_mfma_f32_32x32x16_bf16(kf[2 * s + 1], qf[s], s1, 0, 0, 0);
                }
                s16x4 vl[2][4], vh[2][4];
#define ATT_VLD(bsel_, ks_) do { _Pragma("unroll") for (int c4 = 0; c4 < 4; ++c4) { vl[bsel_][c4] = vtr(Vb + voff[0][c4] + 4096 * (ks_)); vh[bsel_][c4] = vtr(Vb + voff[1][c4] + 4096 * (ks_)); } } while (0)
                ATT_VLD(0, 0);
                __builtin_amdgcn_sched_barrier(0);
                float pm = 0.f, ps = 0.f;
#pragma unroll
                for (int i = 0; i < 16; ++i) { s0[i] = __builtin_amdgcn_exp2f(s0[i]); s1[i] = __builtin_amdgcn_exp2f(s1[i]); }
#pragma unroll
                for (int i = 0; i < 16; i += 2) pm = fmaxf(fmaxf(pm, fmaxf(s0[i], s0[i + 1])), fmaxf(s1[i], s1[i + 1]));
                if (__builtin_expect(__any(pm > 256.f), 0)) {
                    pm = half_max(pm);
                    const float dl = pm > 1.f ? ceilf(__builtin_amdgcn_logf(pm)) : 0.f, f = __builtin_amdgcn_exp2f(-dl);
                    mref += dl; lsum *= f;
#pragma unroll
                    for (int i = 0; i < 16; ++i) { s0[i] *= f; s1[i] *= f; }
#pragma unroll
                    for (int c4 = 0; c4 < 4; ++c4)
#pragma unroll
                        for (int i = 0; i < 16; ++i) o[c4][i] *= f;
                }
#pragma unroll
                for (int i = 0; i < 16; ++i) ps += s0[i] + s1[i];
                lsum += ps;
                bf16x8 pf[4];
#pragma unroll
                for (int s = 0; s < 2; ++s) {
                    u32x4 a, b;
                    a.x = cvtpk(s0[8 * s], s0[8 * s + 1]); a.y = cvtpk(s0[8 * s + 2], s0[8 * s + 3]); a.z = cvtpk(s0[8 * s + 4], s0[8 * s + 5]); a.w = cvtpk(s0[8 * s + 6], s0[8 * s + 7]);
                    b.x = cvtpk(s1[8 * s], s1[8 * s + 1]); b.y = cvtpk(s1[8 * s + 2], s1[8 * s + 3]); b.z = cvtpk(s1[8 * s + 4], s1[8 * s + 5]); b.w = cvtpk(s1[8 * s + 6], s1[8 * s + 7]);
                    pf[s] = __builtin_bit_cast(bf16x8, a); pf[2 + s] = __builtin_bit_cast(bf16x8, b);
                }
#pragma unroll
                for (int ks = 0; ks < 4; ++ks) {
                    if (ks < 3) ATT_VLD((ks + 1) & 1, ks + 1);
                    __builtin_amdgcn_sched_barrier(0);
#pragma unroll
                    for (int c4 = 0; c4 < 4; ++c4) {
                        const s16x4 lo = vl[ks & 1][c4], hi = vh[ks & 1][c4];
                        const bf16x8 vt = (bf16x8){lo[0], lo[1], lo[2], lo[3], hi[0], hi[1], hi[2], hi[3]};
                        o[c4] = __builtin_amdgcn_mfma_f32_32x32x16_bf16(vt, pf[ks], o[c4], 0, 0, 0);
                    }
                    __builtin_amdgcn_sched_barrier(0);
                }
#undef ATT_VLD
            }
        }
    }
    __syncthreads();
    const float ltot = half_sum(lsum), inv = active ? 1.f / ltot : 0.f;
    ALAS float* xch = (ALAS float*)lds + j * 4096;
    if (c == 1 && active) {
#pragma unroll
        for (int c4 = 0; c4 < 4; ++c4)
#pragma unroll
            for (int i = 0; i < 16; ++i) xch[(c4 * 16 + i) * 64 + lane] = o[c4][i] * inv;
    }
    __syncthreads();
    if (c == 0 && active) {
        float ss = 0.f;
#pragma unroll
        for (int c4 = 0; c4 < 4; ++c4)
#pragma unroll
            for (int i = 0; i < 16; ++i) { const float v = o[c4][i] * inv - lam * xch[(c4 * 16 + i) * 64 + lane]; o[c4][i] = v; ss += v * v; }
        ss = half_sum(ss);
        const float rs = 0.8f / sqrtf(ss * (1.f / 128.f) + EPS);
        bf16_t* op = d.O + (size_t)(32 * j + r32) * DM + 4 * hh;
#pragma unroll
        for (int c4 = 0; c4 < 4; ++c4)
#pragma unroll
            for (int g4 = 0; g4 < 4; ++g4) { const int dv0 = 32 * c4 + 8 * g4;
                const f32x4 g = *(const f32x4*)(subg + dv0 + 4 * hh);
                u32x2 pk; pk.x = cvtpk(o[c4][4 * g4] * rs * g[0], o[c4][4 * g4 + 1] * rs * g[1]); pk.y = cvtpk(o[c4][4 * g4 + 2] * rs * g[2], o[c4][4 * g4 + 3] * rs * g[3]);
                *(u32x2*)(op + dv0) = pk; }
    }
    __syncthreads();
}
#undef ATT_DMA
#undef ATT_SB
#undef ATT_KLD
#undef ATT_QK
#undef ATT_VLD2
#undef ATT_PVK
#undef ATT_SOFTMAX
#undef ALAS
}

#define GAS __attribute__((address_space(1)))
#define LAS __attribute__((address_space(3)))
typedef unsigned short bf16;
typedef unsigned v4u __attribute__((ext_vector_type(4)));
typedef unsigned v2u __attribute__((ext_vector_type(2)));
typedef float f32x4 __attribute__((ext_vector_type(4)));
constexpr int NWAVES = 8, NTHREADS = 512;
constexpr int LDS_BYTES = 147456;
constexpr size_t MiB = 1u << 20;
constexpr size_t WS_MOD = 0;
constexpr size_t WS_QCTR = 1 * MiB + 16384, WS_MAXB = 1 * MiB + 32768;
constexpr size_t WS_BAR = 1 * MiB;
constexpr size_t WS_ROWSS = 1 * MiB + 65536;
constexpr size_t WS_SH2 = 30 * MiB;
constexpr size_t WS_BIAS2 = 26 * MiB;
constexpr size_t CTL_BYTES = 65536 + (size_t)MT * 4;
constexpr int MISC_OFF = 131072 + 320;
constexpr size_t WS_WIN = 2 * MiB, WS_WO = 8 * MiB, WS_W1 = 10 * MiB, WS_W2 = 18 * MiB;
constexpr size_t WS_XN = 32 * MiB;
constexpr size_t WS_HB = 192 * MiB;
constexpr size_t WS_BG = 192 * MiB, WS_CG = 257 * MiB, WS_UG = 322 * MiB, WS_QB = 387 * MiB;
constexpr size_t WS_KB = 452 * MiB, WS_VB = 550 * MiB;
constexpr size_t WS_MIX = 648 * MiB;
constexpr size_t WS_END = 778 * MiB;
static_assert((size_t)MT * HW * 2 <= 65 * MiB && (size_t)KVROWS * HW * 2 <= 98 * MiB && (size_t)MT * DM * 2 <= 130 * MiB && (size_t)MT * FF * 2 <= 520 * MiB, "ws map");

__device__ __forceinline__ unsigned f2bf(float f) { unsigned u = __builtin_bit_cast(unsigned, f); return (u + 0x7fffu + ((u >> 16) & 1u)) >> 16; }
__device__ __forceinline__ unsigned pk2(float lo, float hi) { return f2bf(lo) | (f2bf(hi) << 16); }
__device__ __forceinline__ float bflo(unsigned u) { return __builtin_bit_cast(float, u << 16); }
__device__ __forceinline__ float bfhi(unsigned u) { return __builtin_bit_cast(float, u & 0xffff0000u); }
__device__ __forceinline__ float wave_sum(float v) {
#pragma unroll
    for (int o = 1; o < 64; o <<= 1) v += __shfl_xor(v, o);
    return v;
}
#define LDS_WAIT() asm volatile("s_waitcnt lgkmcnt(0)" ::: "memory")

#define XB_TMO      128
#define XB_XCNT(j)  (256  + 64 * (j))
#define XB_XSUB(j)  (1280 + 64 * (j))
#define XB_XGEN(j)  (2304 + 64 * (j))
#define XB_TOP      3328
#define XB_TOPGEN   3392
#define XCD_BAR_WORDS 3456
#define XB_SPIN_CAP (1u << 18)

__device__ __forceinline__ unsigned xb_ld(unsigned* p)              { return __hip_atomic_load(p, __ATOMIC_RELAXED, __HIP_MEMORY_SCOPE_AGENT); }
__device__ __forceinline__ unsigned xb_add(unsigned* p, unsigned v) { return __hip_atomic_fetch_add(p, v, __ATOMIC_RELAXED, __HIP_MEMORY_SCOPE_AGENT); }
__device__ __forceinline__ unsigned xb_xcc_id() { return (unsigned)__builtin_amdgcn_s_getreg((3 << 11) | 20) & 0xFu; }
#define XB_SPIN(cond, bar) do { unsigned _sp = 0; while (cond) { __builtin_amdgcn_s_sleep(1); \
    if ((++_sp & 255u) == 0u) { if (xb_ld(&(bar)[XB_TMO])) break; if (_sp > XB_SPIN_CAP) { atomicAdd(&(bar)[XB_TMO], 1u); break; } } } } while (0)

struct XcdBarrier {
    unsigned* bar; unsigned x;
    volatile LAS unsigned* st;
};

__device__ __forceinline__ XcdBarrier xcd_barrier_post(unsigned* bar, volatile LAS unsigned* st) {
    XcdBarrier b; b.bar = bar; b.x = xb_xcc_id(); b.st = st;
    if (threadIdx.x == 0) (void)xb_add(&bar[XB_XCNT(b.x)], 1u);
    return b;
}
__device__ __forceinline__ void xcd_barrier_complete(unsigned* bar, unsigned x, unsigned& nloc, unsigned& nx) {
    const unsigned G = gridDim.x * gridDim.y * gridDim.z;
    unsigned sum, cnt, mine, sp = 0u;
    for (;;) {
        sum = 0u; cnt = 0u; mine = 0u;
#pragma unroll
        for (unsigned j = 0; j < 16; ++j) { const unsigned c = xb_ld(&bar[XB_XCNT(j)]); sum += c; cnt += (c > 0u) ? 1u : 0u; mine = (j == x) ? c : mine; }
        if (sum == G) break;
        __builtin_amdgcn_s_sleep(1);
        if ((++sp & 255u) == 0u) { if (xb_ld(&bar[XB_TMO])) break; if (sp > XB_SPIN_CAP) { atomicAdd(&bar[XB_TMO], 1u); break; } }
    }
    nloc = mine > 0u ? mine : 1u; nx = cnt > 0u ? cnt : 1u;
}

__device__ __forceinline__ void xcd_barrier(const XcdBarrier& b) {
    asm volatile("s_waitcnt vmcnt(0)" ::: "memory");
    __syncthreads();
    if (threadIdx.x == 0) {
        unsigned* bar = b.bar;
        __builtin_amdgcn_s_waitcnt(0);
        unsigned nloc = b.st[0], nx = b.st[1];
        if (nloc == 0u) { xcd_barrier_complete(bar, b.x, nloc, nx); b.st[0] = nloc; b.st[1] = nx; }
        const unsigned old = xb_add(&bar[XB_XSUB(b.x)], 1u);
        const unsigned gen = old / nloc;
        if (old + 1u == (gen + 1u) * nloc) {
            __builtin_amdgcn_fence(__ATOMIC_RELEASE, "agent");
            asm volatile("s_waitcnt vmcnt(0)" ::: "memory");
            const unsigned og = xb_add(&bar[XB_TOP], 1u);
            const unsigned tg = og / nx;
            if (og + 1u == (tg + 1u) * nx) xb_add(&bar[XB_TOPGEN], 1u);
            else XB_SPIN(xb_ld(&bar[XB_TOPGEN]) == tg, bar);
            __builtin_amdgcn_fence(__ATOMIC_ACQUIRE, "agent");
            xb_add(&bar[XB_XGEN(b.x)], 1u);
            asm volatile("s_waitcnt vmcnt(0)" ::: "memory");
        } else {
            XB_SPIN(xb_ld(&bar[XB_XGEN(b.x)]) == gen, bar);
            __builtin_amdgcn_fence(__ATOMIC_ACQUIRE, "agent");
            asm volatile("s_waitcnt vmcnt(0)" ::: "memory");
        }
    }
    __syncthreads();
}


struct Args {
    const float *x_p, *x_s, *cache_k, *cache_v, *state_conv, *c_p, *c_s, *norm1_g, *norm2_g, *w_ada, *b_ada, *w_in, *conv_w, *lq1, *lk1, *lq2, *lk2, *subln_g, *w_o, *w_mlp1, *w_mlp2, *final_g;
    float* out; unsigned char* ws; int never; int pad;
};

__device__ __forceinline__ void p0_transpose_item(const float* W, int K, int N, bf16* WT, LAS float* scr, int item, int lane) {
    const int nblk = N / 32, kb = item / nblk, nb = item % nblk, k0 = 64 * kb, n0 = 32 * nb;
#pragma unroll 8
    for (int i = 0; i < 32; ++i) { const int kk = 2 * i + (lane >> 5); scr[kk * 33 + (lane & 31)] = W[(size_t)(k0 + kk) * N + n0 + (lane & 31)]; }
    LDS_WAIT(); asm volatile("" ::: "memory");
    const int c = lane & 7;
#pragma unroll
    for (int j = 0; j < 4; ++j) { const int n = (lane >> 3) + 8 * j; const LAS float* s = scr + (8 * c) * 33 + n;
        v4u o; o.x = pk2(s[0 * 33], s[1 * 33]); o.y = pk2(s[2 * 33], s[3 * 33]); o.z = pk2(s[4 * 33], s[5 * 33]); o.w = pk2(s[6 * 33], s[7 * 33]);
        *(GAS v4u*)(WT + (size_t)(n0 + n) * K + k0 + 8 * c) = o; }
    LDS_WAIT(); asm volatile("" ::: "memory");
}

__device__ __forceinline__ void norm_mod_row(const float* xrow, const float* g, const float* sc, const float* sh, bf16* orow, int lane) {
    const f32x4* xr = (const f32x4*)xrow + lane;
    f32x4 v[4]; float s = 0.f;
#pragma unroll
    for (int j = 0; j < 4; ++j) { v[j] = xr[64 * j]; s += (v[j].x * v[j].x + v[j].y * v[j].y) + (v[j].z * v[j].z + v[j].w * v[j].w); }
    const float rstd = 1.f / sqrtf(wave_sum(s) * (1.f / DM) + EPS);
    unsigned long long* o8 = (unsigned long long*)orow + lane;
#pragma unroll
    for (int j = 0; j < 4; ++j) { const f32x4 gg = ((const f32x4*)g)[lane + 64 * j], cc = ((const f32x4*)sc)[lane + 64 * j], hh = ((const f32x4*)sh)[lane + 64 * j];
        const f32x4 r = v[j] * rstd * gg * (cc + 1.f) + hh;
        o8[64 * j] = (unsigned long long)pk2(r.x, r.y) | ((unsigned long long)pk2(r.z, r.w) << 32); }
}

__global__ void __launch_bounds__(NTHREADS, 2) mega_fwd(Args a) {
    extern __shared__ __attribute__((aligned(16))) unsigned char lds_raw[];
    LAS unsigned char* lds = (LAS unsigned char*)lds_raw;
    cg::grid_group grid = cg::this_grid();
    const int G = gridDim.x; const int bx = blockIdx.x;
    const int vcu = (G % 8 == 0) ? (bx % 8) * (G / 8) + bx / 8 : bx;
    const int NGW = G * NWAVES;
#define PHASE_IDS() int tid_ = threadIdx.x; asm volatile("" : "+v"(tid_)); const int tid = tid_, lane = tid & 63, wave = __builtin_amdgcn_readfirstlane(tid >> 6), gw = vcu * NWAVES + wave; (void)tid; (void)lane; (void)gw
    unsigned char* ws = a.ws;
    float* mod = (float*)(ws + WS_MOD); float* rowss = (float*)(ws + WS_ROWSS); float* bias2 = (float*)(ws + WS_BIAS2); bf16* SH2 = (bf16*)(ws + WS_SH2);
    bf16 *Win_t = (bf16*)(ws + WS_WIN), *Wo_t = (bf16*)(ws + WS_WO), *W1_t = (bf16*)(ws + WS_W1), *W2_t = (bf16*)(ws + WS_W2);
    bf16 *XN = (bf16*)(ws + WS_XN), *HB = (bf16*)(ws + WS_HB), *BG = (bf16*)(ws + WS_BG), *CG = (bf16*)(ws + WS_CG), *UG = (bf16*)(ws + WS_UG), *QB = (bf16*)(ws + WS_QB);
    bf16 *KB = (bf16*)(ws + WS_KB), *VB = (bf16*)(ws + WS_VB), *MIX = (bf16*)(ws + WS_MIX);
    volatile LAS unsigned* MISC = (volatile LAS unsigned*)(lds + MISC_OFF);
    if (threadIdx.x < 32) MISC[threadIdx.x] = 0u;
    unsigned* barw = (unsigned*)(ws + WS_BAR);
    unsigned* qctr = (unsigned*)(ws + WS_QCTR); unsigned* maxbuf = (unsigned*)(ws + WS_MAXB);
    __syncthreads();
    const XcdBarrier bar = xcd_barrier_post(barw, MISC + 8);
#define GRID_SYNC() xcd_barrier(bar)
    if (a.never) grid.sync();

    { PHASE_IDS();
    if (bx < (6 * DM) / 64) {
        const int cb = bx * 64;
        LAS float* sl = (LAS float*)lds + wave * (64 * NMOD);
        float acc[NMOD];
#pragma unroll
        for (int r = 0; r < NMOD; ++r) acc[r] = 0.f;
        for (int half = 0; half < 2; ++half) {
            const int k0 = wave * 128 + half * 64;
            for (int idx = lane; idx < 64 * NMOD; idx += 64) { const int kk = idx & 63, r = idx >> 6;
                const float cv = r < NB_P ? a.c_p[r * DM + k0 + kk] : a.c_s[(r - NB_P) * DM + k0 + kk];
                sl[kk * NMOD + r] = cv / (1.f + __expf(-cv)); }
            LDS_WAIT(); asm volatile("" ::: "memory");
            for (int kk = 0; kk < 64; ++kk) {
                const float wv = a.w_ada[(size_t)(k0 + kk) * (6 * DM) + cb + lane];
                const LAS f32x4* sp = (const LAS f32x4*)(sl + kk * NMOD);
#pragma unroll
                for (int r4 = 0; r4 < NMOD / 4; ++r4) { const f32x4 sv = sp[r4]; acc[4 * r4] += sv.x * wv; acc[4 * r4 + 1] += sv.y * wv; acc[4 * r4 + 2] += sv.z * wv; acc[4 * r4 + 3] += sv.w * wv; }
            }
            LDS_WAIT(); asm volatile("" ::: "memory");
        }
        __syncthreads();
        LAS float* red = (LAS float*)lds;
#pragma unroll
        for (int r = 0; r < NMOD; ++r) red[(wave * NMOD + r) * 64 + lane] = acc[r];
        __syncthreads();
        for (int idx = tid; idx < NMOD * 64; idx += NTHREADS) { const int r = idx >> 6, cl = idx & 63; float s = a.b_ada[cb + cl];
#pragma unroll
            for (int w8 = 0; w8 < 8; ++w8) s += red[(w8 * NMOD + r) * 64 + cl];
            mod[(size_t)r * (6 * DM) + cb + cl] = s; }
        __syncthreads();
    }
    {
        LAS float* scr = (LAS float*)(lds + wave * 16384);
        constexpr int I_IN = (DM / 64) * (INW / 32), I_O = (DM / 64) * (DM / 32), I_1 = (DM / 64) * (FF / 32), I_2 = (FF / 64) * (DM / 32);
        constexpr int NITEMS = I_IN + I_O + I_1 + I_2;
        for (int it = gw; it < NITEMS; it += NGW) {
            int r = it;
            if (r < I_IN) { p0_transpose_item(a.w_in, DM, INW, Win_t, scr, r, lane); continue; } r -= I_IN;
            if (r < I_O) { p0_transpose_item(a.w_o, DM, DM, Wo_t, scr, r, lane); continue; } r -= I_O;
            if (r < I_1) { p0_transpose_item(a.w_mlp1, DM, FF, W1_t, scr, r, lane); continue; } r -= I_1;
            p0_transpose_item(a.w_mlp2, FF, DM, W2_t, scr, r, lane);
        }
        constexpr int NC = NB_S * PAST;
        for (int it = gw; it < 2 * NC; it += NGW) {
            const int which = it >= NC, r = which ? it - NC : it, b = r >> 10, t = r & 1023;
            const float* src = (which ? a.cache_v : a.cache_k) + (size_t)r * HW + lane * 8;
            const f32x4 v0 = *(const f32x4*)src, v1 = *(const f32x4*)(src + 4);
            v4u o; o.x = pk2(v0.x, v0.y); o.y = pk2(v0.z, v0.w); o.z = pk2(v1.x, v1.y); o.w = pk2(v1.z, v1.w);
            *(v4u*)((which ? VB : KB) + (size_t)(MP + b * KVS + t) * HW + lane * 8) = o;
        }
        for (int it = gw; it < 2 * NB_S * 32; it += NGW) {
            const int which = it >= NB_S * 32, r = which ? it - NB_S * 32 : it, b = r >> 5, t = PAST + T_S + (r & 31);
            *(v4u*)((which ? VB : KB) + (size_t)(MP + b * KVS + t) * HW + lane * 8) = (v4u){0u, 0u, 0u, 0u};
        }
    }
    }
    GRID_SYNC();

    { PHASE_IDS();
    if (gw < 256) { unsigned long long* o8 = (unsigned long long*)(SH2 + (size_t)gw * DM) + lane; const f32x4* sp = (const f32x4*)(mod + (size_t)(gw < NMOD ? gw : 0) * (6 * DM) + 3 * DM) + lane;
#pragma unroll
        for (int j = 0; j < 4; ++j) { f32x4 r = sp[64 * j]; if (gw >= NMOD) r = (f32x4){0.f, 0.f, 0.f, 0.f}; o8[64 * j] = (unsigned long long)pk2(r.x, r.y) | ((unsigned long long)pk2(r.z, r.w) << 32); } }
    for (int m = gw; m < MT; m += NGW) {
        const int mrow = m < MP ? (m >> 13) : NB_P + ((m - MP) >> 5);
        const float* xr = m < MP ? a.x_p + (size_t)m * DM : a.x_s + (size_t)(m - MP) * DM;
        const float* mr = mod + (size_t)mrow * (6 * DM);
        norm_mod_row(xr, a.norm1_g, mr + DM, mr, XN + (size_t)m * DM, lane);
    } }
    GRID_SYNC();

    {
        pg8::Gemm g{XN, Win_t, MT, INW, DM}; pg8::StaticOrder S; S.init(MT, INW, G, bx, 1);
        pg8::EpiIn E{BG, CG, UG, QB, KB, VB, a.out, maxbuf};
        pg8::gemm_phase<pg8::EpiIn, pg8::StaticOrder, true, true>(lds, g, S, E);
    }
    GRID_SYNC();

    { PHASE_IDS();
        float lam;
        { float d1 = 0.f, d2 = 0.f; for (int i = 0; i < 64; ++i) { d1 += a.lq1[i] * a.lk1[i]; d2 += a.lq2[i] * a.lk2[i]; } lam = __expf(d1) - __expf(d2) + 0.2f; }
        constexpr int NQI = 256 + (NB_S * 4) / 8;
        int qi = (int)(bar.x & 7u);
        for (int nq = 0; nq < 8;) {
            if (tid == 0) MISC[0] = __hip_atomic_fetch_add(qctr + 64 * qi, 1u, __ATOMIC_RELAXED, __HIP_MEMORY_SCOPE_AGENT);
            __syncthreads();
            const int idx = (int)MISC[0];
            __syncthreads();
            if (idx >= NQI) { qi = (qi + 1) & 7; ++nq; continue; }
            att::UnitDesc d;
            if (idx < 256) {
                const int b = qi, h = 3 - (idx >> 6), qb = 63 - (idx & 63);
                const size_t row0 = (size_t)b * T_P + 128 * qb;
                d.Q = QB + row0 * HW + h * 128; d.K = KB + (size_t)b * T_P * HW + h * 128; d.V = VB + (size_t)b * T_P * HW + h * 128; d.O = MIX + row0 * DM + 512 + h * 128;
                d.q0pos = 128 * qb; d.nvalid = 128; d.kv_len = T_P; d.s_hi = qb; d.slope2 = LOG2E * exp2f(-2.f * (float)(h + 1));
                const unsigned* mq = maxbuf + b * 16 + h * 4; const unsigned* mk = mq + 128;
                const float B0 = sqrtf(__uint_as_float(mq[0]) * __uint_as_float(mk[0])) + sqrtf(__uint_as_float(mq[1]) * __uint_as_float(mk[1]));
                const float B1 = sqrtf(__uint_as_float(mq[2]) * __uint_as_float(mk[2])) + sqrtf(__uint_as_float(mq[3]) * __uint_as_float(mk[3]));
                const float Tn = 2.04f * fmaxf(B0, B1) + 160.f, X = ((float)d.q0pos - 127.f - Tn / d.slope2) * (1.f / 128.f);
                int slo = X > 0.f ? (int)floorf(X) : 0; d.s_lo = slo < qb ? slo : qb;
            } else {
                const int us = qi * ((NB_S * 4) / 8) + idx - 256, b = us >> 2, h = us & 3;
                const size_t row0 = (size_t)MP + b * T_S, kr0 = (size_t)MP + (size_t)b * KVS;
                d.Q = QB + row0 * HW + h * 128; d.K = KB + kr0 * HW + h * 128; d.V = VB + kr0 * HW + h * 128; d.O = MIX + row0 * DM + 512 + h * 128;
                d.q0pos = PAST; d.nvalid = T_S; d.kv_len = PAST + T_S; d.s_hi = (KVS / 64) / 2; d.s_lo = 0; d.slope2 = LOG2E * exp2f(-2.f * (float)(h + 1));
            }
            att::attn_unit(lds, d, lam, a.subln_g);
        }
        const int ch0 = lane * 8;
        float w0[8], w1[8], w2[8];
#pragma unroll
        for (int e = 0; e < 8; ++e) { w0[e] = a.conv_w[ch0 + e]; w1[e] = a.conv_w[HW + ch0 + e]; w2[e] = a.conv_w[2 * HW + ch0 + e]; }
        for (int r = gw; r < MT; r += NGW) {
            const bool smp = r >= MP; const int t = smp ? ((r - MP) & 31) : (r & (T_P - 1)), T = smp ? T_S : T_P, b = smp ? ((r - MP) >> 5) : (r >> 13);
            float uc[3][8];
#pragma unroll
            for (int k = 0; k < 3; ++k) {
                if (t - k >= 0) { const v4u cv = *(const v4u*)(CG + (size_t)(r - k) * HW + ch0), uv = *(const v4u*)(UG + (size_t)(r - k) * HW + ch0);
                    uc[k][0] = bflo(cv.x) * bflo(uv.x); uc[k][1] = bfhi(cv.x) * bfhi(uv.x); uc[k][2] = bflo(cv.y) * bflo(uv.y); uc[k][3] = bfhi(cv.y) * bfhi(uv.y);
                    uc[k][4] = bflo(cv.z) * bflo(uv.z); uc[k][5] = bfhi(cv.z) * bfhi(uv.z); uc[k][6] = bflo(cv.w) * bflo(uv.w); uc[k][7] = bfhi(cv.w) * bfhi(uv.w);
                } else if (smp) { const float* sp = a.state_conv + ((size_t)b * 2 + (2 + t - k)) * HW + ch0; const f32x4 s0 = *(const f32x4*)sp, s1 = *(const f32x4*)(sp + 4);
                    uc[k][0] = s0.x; uc[k][1] = s0.y; uc[k][2] = s0.z; uc[k][3] = s0.w; uc[k][4] = s1.x; uc[k][5] = s1.y; uc[k][6] = s1.z; uc[k][7] = s1.w;
                } else {
#pragma unroll
                    for (int e = 0; e < 8; ++e) uc[k][e] = 0.f; }
            }
            const v4u bv = *(const v4u*)(BG + (size_t)r * HW + ch0);
            float bb[8] = {bflo(bv.x), bfhi(bv.x), bflo(bv.y), bfhi(bv.y), bflo(bv.z), bfhi(bv.z), bflo(bv.w), bfhi(bv.w)};
            float y[8];
#pragma unroll
            for (int e = 0; e < 8; ++e) y[e] = bb[e] * (w0[e] * uc[2][e] + w1[e] * uc[1][e] + w2[e] * uc[0][e]);
            v4u o; o.x = pk2(y[0], y[1]); o.y = pk2(y[2], y[3]); o.z = pk2(y[4], y[5]); o.w = pk2(y[6], y[7]);
            *(v4u*)(MIX + (size_t)r * DM + ch0) = o;
            if (t >= T - 2) { float* cp = a.out + (smp ? O_CS : O_CP) + ((size_t)b * 2 + (t - (T - 2))) * HW + ch0;
                *(f32x4*)cp = (f32x4){uc[0][0], uc[0][1], uc[0][2], uc[0][3]}; *(f32x4*)(cp + 4) = (f32x4){uc[0][4], uc[0][5], uc[0][6], uc[0][7]}; }
        }
    }
    GRID_SYNC();

    {
        pg8::Gemm g{MIX, Wo_t, MT, DM, DM}; pg8::StaticOrder S; S.init(MT, DM, G, bx);
        pg8::EpiResGate2 E{a.x_p, a.x_s, a.out, mod + 2 * DM, mod + 4 * DM, a.norm2_g, XN, rowss};
        pg8::gemm_phase<pg8::EpiResGate2, pg8::StaticOrder, true, true>(lds, g, S, E);
        const int c2 = G >= 48 ? bx - 16 : bx;
        if (c2 >= 0 && c2 < 16) { pg8::Gemm gb{SH2, W1_t, 256, FF, DM, 0}; pg8::SplitOrder Sb{1, FF / 256, 1, 1, 16, c2};
            pg8::EpiPartial Eb{bias2, 1, 256, FF};
            pg8::gemm_phase<pg8::EpiPartial, pg8::SplitOrder, true, true>(lds, gb, Sb, Eb); }
    }
    GRID_SYNC();

    {
        pg8::Gemm g{XN, W1_t, MT, FF, DM}; pg8::StaticOrder S; S.init(MT, FF, G, bx);
        pg8::EpiRelu2N E{HB, FF, rowss, bias2};
        pg8::gemm_phase<pg8::EpiRelu2N, pg8::StaticOrder, true, true>(lds, g, S, E);
    }
    GRID_SYNC();

    {
        pg8::Gemm g{HB, W2_t, MP, DM, FF}; pg8::StaticOrder S; S.init(MP, DM, G, bx);
        pg8::EpiResGate E{a.out, a.out + (size_t)MP * DM, a.out, mod + 5 * DM};
        pg8::gemm_phase<pg8::EpiResGate, pg8::StaticOrder, true, true>(lds, g, S, E);
        pg8::Gemm g2{HB + (size_t)MP * FF, W2_t, MS, DM, FF, 256}; pg8::SplitOrder S2{MS / 256, DM / 256, FF / 256, 256, G, bx};
        pg8::EpiPartial E2{(float*)(ws + WS_XN), 256, MS, DM};
        pg8::gemm_phase<pg8::EpiPartial, pg8::SplitOrder, true, true>(lds, g2, S2, E2);
    }
    GRID_SYNC();

    { PHASE_IDS();
    for (int m = gw; m < MT; m += NGW) {
        f32x4* xr = (f32x4*)(a.out + (size_t)m * DM) + lane;
        f32x4 v[4]; float s = 0.f;
#pragma unroll
        for (int j = 0; j < 4; ++j) v[j] = xr[64 * j];
        if (m >= MP) {
            const f32x4* pp = (const f32x4*)(ws + WS_XN) + (size_t)(m - MP) * (DM / 4) + lane; const f32x4* gp = (const f32x4*)(mod + (size_t)(NB_P + ((m - MP) >> 5)) * (6 * DM) + 5 * DM) + lane;
#pragma unroll
            for (int j = 0; j < 4; ++j) { f32x4 t = pp[64 * j];
                for (int s2 = 1; s2 < FF / 256; ++s2) t += pp[(size_t)s2 * MS * (DM / 4) + 64 * j];
                v[j] += gp[64 * j] * t; }
        }
#pragma unroll
        for (int j = 0; j < 4; ++j) s += (v[j].x * v[j].x + v[j].y * v[j].y) + (v[j].z * v[j].z + v[j].w * v[j].w);
        const float rstd = 1.f / sqrtf(wave_sum(s) * (1.f / DM) + EPS);
#pragma unroll
        for (int j = 0; j < 4; ++j) xr[64 * j] = v[j] * rstd * ((const f32x4*)a.final_g)[lane + 64 * j];
    } }
}

extern "C" void kernel_launch(void* const* d_in, const int* in_sizes, int n_in, void* d_out, int out_size, void* d_ws, size_t ws_size, hipStream_t stream) {
    static int grid = 0;
    if (grid == 0) {
        if (n_in != 22 || in_sizes[0] != MP * DM || (size_t)out_size != O_END || ws_size < WS_END) {
            fprintf(stderr, "kernel_launch: unexpected shapes: n_in %d in0 %d out %d ws %zu (need %zu)\n", n_in, n_in > 0 ? in_sizes[0] : -1, out_size, ws_size, (size_t)WS_END); grid = -1; return; }
        int dev = 0, cus = 0, per_cu = 0;
        (void)hipGetDevice(&dev); (void)hipDeviceGetAttribute(&cus, hipDeviceAttributeMultiprocessorCount, dev);
        if (hipFuncSetAttribute((const void*)mega_fwd, hipFuncAttributeMaxDynamicSharedMemorySize, LDS_BYTES) != hipSuccess) { fprintf(stderr, "kernel_launch: hipFuncSetAttribute failed\n"); grid = -1; return; }
        if (hipOccupancyMaxActiveBlocksPerMultiprocessor(&per_cu, (const void*)mega_fwd, NTHREADS, LDS_BYTES) != hipSuccess || per_cu < 1) { fprintf(stderr, "kernel_launch: occupancy query says %d\n", per_cu); per_cu = 1; }
        (void)hipGetLastError();
        grid = cus * per_cu;
        fprintf(stderr, "kernel_launch: grid %d (cus %d x %d)\n", grid, cus, per_cu);
    }
    if (grid < 0) return;
    Args a{};
    const float** p = (const float**)&a;
    for (int i = 0; i < 22; ++i) p[i] = (const float*)d_in[i];
    a.out = (float*)d_out; a.ws = (unsigned char*)d_ws;
    if (hipMemsetAsync((char*)d_ws + WS_BAR, 0, CTL_BYTES, stream) != hipSuccess) { fprintf(stderr, "kernel_launch: hipMemsetAsync failed\n"); return; }
    void* args[] = {&a};
    hipError_t e = hipLaunchCooperativeKernel((const void*)mega_fwd, dim3(grid), dim3(NTHREADS), args, LDS_BYTES, stream);
    if (e != hipSuccess) fprintf(stderr, "kernel_launch: cooperative launch failed: %s (grid %d)\n", hipGetErrorString(e), grid);
}
```

```cpp
#include <hip/hip_runtime.h>
#include <hip/hip_cooperative_groups.h>
#include <cstdio>
#include <cstdint>
namespace cg = cooperative_groups;

constexpr int DM = 1024, NB_P = 8, T_P = 8192, NB_S = 32, T_S = 32, PAST = 1024;
constexpr int MP = NB_P * T_P, MS = NB_S * T_S, MT = MP + MS;
constexpr int INW = 3072, FF = 4096, HW = 512;
constexpr int KVS = 1088;
constexpr int KVROWS = MP + NB_S * KVS;
constexpr int NMOD = NB_P + NB_S;
constexpr float EPS = 1e-5f;
constexpr float LOG2E = 1.4426950408889634f;
constexpr float QSCALE = 0.125f * LOG2E;
constexpr size_t O_YP = 0, O_YS = (size_t)MP * DM, O_KP = O_YS + (size_t)MS * DM, O_VP = O_KP + (size_t)MP * HW, O_CP = O_VP + (size_t)MP * HW,
                 O_KS = O_CP + (size_t)NB_P * 2 * HW, O_VS = O_KS + (size_t)MS * HW, O_CS = O_VS + (size_t)MS * HW, O_END = O_CS + (size_t)NB_S * 2 * HW;

namespace pg8 {
#define PG8_LAS __attribute__((address_space(3)))
typedef unsigned short bf16_t;
typedef short bf16x8 __attribute__((ext_vector_type(8)));
typedef float f32x4 __attribute__((ext_vector_type(4)));
typedef unsigned u32x4 __attribute__((ext_vector_type(4)));
constexpr int BM = 256, BK = 64, HALF = 128, HTB = HALF * BK * 2  , STAGE_BYTES = 8 * HTB, NXCD = 8, WGM = 8;

__host__ __device__ __forceinline__ int lds_byte(int r, int c) { const int st = (r >> 4) * 2 + (c >> 5), rr = r & 15, cc = c & 31, ob = rr * 64 + cc * 2; return st * 1024 + (ob ^ (((ob >> 9) & 1) << 5)); }
__host__ __device__ __forceinline__ void stage_rc(int b, int& R, int& C) { const int st = b / 1024, sb = b % 1024, swz = sb ^ (((sb >> 9) & 1) << 5); R = (st >> 1) * 16 + swz / 64; C = (st & 1) * 32 + (swz % 64) / 2; }
__host__ __device__ __forceinline__ int perm32(int rho) { const int n = rho >> 4, i = rho & 15; return 8 * (i >> 2) + 4 * n + (i & 3); }

struct Unit { int pm, pn, k0; };
struct Gemm { const bf16_t* A; const bf16_t* Bt; int M, N, K, Kext; };

struct StaticOrder {
    int nM, nN, nwg, G, c, rot;
    __host__ __device__ void init(int M, int N, int G_, int c_, int rot_ = 0) { nM = M / BM; nN = N / BM; nwg = nM * nN; G = G_; c = c_; rot = rot_; }
    __host__ __device__ bool next(int i, Unit& u) const {
        const long L = (long)i * G + c; if (L >= nwg) return false;
        int wgid = (int)L; { const int q = nwg / NXCD, r = nwg % NXCD, xcd = wgid % NXCD, off = wgid / NXCD; wgid = (xcd < r ? xcd * (q + 1) : r * (q + 1) + (xcd - r) * q) + off; }
        const int nig = WGM * nN, gid = wgid / nig, fm = gid * WGM, gsz = (nM - fm) < WGM ? (nM - fm) : WGM;
        u.pm = fm + ((wgid % nig) % gsz); u.pn = ((wgid % nig) / gsz + (rot ? ((gid >> 2) * 3) % nN : 0)) % nN; u.k0 = 0; return true;
    }
    __device__ __forceinline__ void a_ready(const Unit&) const {}
    __device__ __forceinline__ void done(const Unit&) const {}
};

struct SplitOrder {
    int nM, nN, nS, ksz, G, c;
    __host__ __device__ bool next(int i, Unit& u) const { const int L = i * G + c; if (L >= nM * nN * nS) return false; u.pm = L % nM; u.pn = (L / nM) % nN; u.k0 = (L / (nM * nN)) * ksz; return true; }
    __device__ __forceinline__ void a_ready(const Unit&) const {}
    __device__ __forceinline__ void done(const Unit&) const {}
};

__device__ __forceinline__ unsigned cvt_pk_bf16(float lo, float hi) { unsigned r; asm volatile("v_cvt_pk_bf16_f32 %0, %1, %2" : "=v"(r) : "v"(lo), "v"(hi)); return r; }
__device__ __forceinline__ u32x4 pack8(f32x4 v0, f32x4 v1) { u32x4 w; w.x = cvt_pk_bf16(v0[0], v0[1]); w.y = cvt_pk_bf16(v0[2], v0[3]); w.z = cvt_pk_bf16(v1[0], v1[1]); w.w = cvt_pk_bf16(v1[2], v1[3]); return w; }

__device__ __forceinline__ float fq_sum(float v) {
    auto a = __builtin_amdgcn_permlane16_swap(__float_as_uint(v), __float_as_uint(v), false, false); v = __uint_as_float(a[0]) + __uint_as_float(a[1]);
    auto b = __builtin_amdgcn_permlane32_swap(__float_as_uint(v), __float_as_uint(v), false, false); return __uint_as_float(b[0]) + __uint_as_float(b[1]); }
struct EpiIn {
    static constexpr bool PERM = true, AFTER_DRAIN = false;
    bf16_t *BG, *CG, *UG, *QB, *KB, *VB; float* out; unsigned* maxbuf;
    __device__ __forceinline__ void operator()(const f32x4 (&acc)[2][2][4][2], const Unit& u, int wr, int wc, int fr, int fq) const {
        const int seg = u.pn >> 1, col0 = (u.pn & 1) * 256 + wc * 32 + 8 * fq, row0 = u.pm * BM + wr * 64 + fr;
        const bool smp = u.pm >= (MP / BM);
        if (!smp && (seg == 3 || seg == 4)) {
            const float sc2 = seg == 3 ? QSCALE * QSCALE : 1.f; float mx[2] = {0.f, 0.f};
#pragma unroll
            for (int ai = 0; ai < 2; ++ai)
#pragma unroll
                for (int m = 0; m < 4; ++m)
#pragma unroll
                    for (int bj = 0; bj < 2; ++bj) { const f32x4 v0 = acc[ai][bj][m][0], v1 = acc[ai][bj][m][1];
                        float ss = (v0[0] * v0[0] + v0[1] * v0[1]) + (v0[2] * v0[2] + v0[3] * v0[3]) + (v1[0] * v1[0] + v1[1] * v1[1]) + (v1[2] * v1[2] + v1[3] * v1[3]);
                        ss = fq_sum(ss); mx[bj] = fmaxf(mx[bj], ss * sc2); }
#pragma unroll
            for (int bj = 0; bj < 2; ++bj)
                if (fq == 0) atomicMax(maxbuf + (seg == 4 ? 128 : 0) + (u.pm >> 5) * 16 + (u.pn & 1) * 8 + bj * 4 + wc, __float_as_uint(mx[bj]));
        }
        if (seg < 4) {
            bf16_t* base = seg == 0 ? BG : seg == 1 ? CG : seg == 2 ? UG : QB; const float sc = seg == 3 ? QSCALE : 1.f;
#pragma unroll
            for (int ai = 0; ai < 2; ++ai)
#pragma unroll
                for (int m = 0; m < 4; ++m) { bf16_t* rowp = base + (size_t)(row0 + ai * HALF + m * 16) * HW + col0;
#pragma unroll
                    for (int bj = 0; bj < 2; ++bj) *(u32x4*)(rowp + bj * HALF) = pack8(acc[ai][bj][m][0] * sc, acc[ai][bj][m][1] * sc); }
        } else {
            bf16_t* kvb = seg == 4 ? KB : VB;
            float* ob = out + (smp ? (seg == 4 ? O_KS : O_VS) : (seg == 4 ? O_KP : O_VP));
#pragma unroll
            for (int ai = 0; ai < 2; ++ai)
#pragma unroll
                for (int m = 0; m < 4; ++m) { const int row = row0 + ai * HALF + m * 16; const int rs = row - MP;
                    const size_t orow = smp ? (size_t)rs : (size_t)row;
                    const size_t kvrow = smp ? (size_t)(MP + (rs >> 5) * KVS + PAST + (rs & 31)) : (size_t)row;
                    float* op = ob + orow * HW + col0; bf16_t* kp = kvb + kvrow * HW + col0;
#pragma unroll
                    for (int bj = 0; bj < 2; ++bj) { const f32x4 v0 = acc[ai][bj][m][0], v1 = acc[ai][bj][m][1];
                        __builtin_nontemporal_store(v0, (f32x4*)(op + bj * HALF)); __builtin_nontemporal_store(v1, (f32x4*)(op + bj * HALF + 4)); *(u32x4*)(kp + bj * HALF) = pack8(v0, v1); } }
        }
    }
};
struct EpiResGate {
    static constexpr bool PERM = true, AFTER_DRAIN = false;
    const float* res_p; const float* res_s; float* out; const float* gate;
    __device__ __forceinline__ void operator()(const f32x4 (&acc)[2][2][4][2], const Unit& u, int wr, int wc, int fr, int fq) const {
        const int col0 = u.pn * BM + wc * 32 + 8 * fq, row0 = u.pm * BM + wr * 64 + fr;
#pragma unroll
        for (int ai = 0; ai < 2; ++ai)
#pragma unroll
            for (int m = 0; m < 4; ++m) { const int row = row0 + ai * HALF + m * 16;
                const int mrow = row < MP ? (row >> 13) : NB_P + ((row - MP) >> 5);
                const float* rp = (row < MP ? res_p + (size_t)row * DM : res_s + (size_t)(row - MP) * DM) + col0;
                const float* gp = gate + (size_t)mrow * (6 * DM) + col0; float* op = out + (size_t)row * DM + col0;
#pragma unroll
                for (int bj = 0; bj < 2; ++bj) {
                    const f32x4 g0 = *(const f32x4*)(gp + bj * HALF), g1 = *(const f32x4*)(gp + bj * HALF + 4);
                    const f32x4 x0 = *(const f32x4*)(rp + bj * HALF), x1 = *(const f32x4*)(rp + bj * HALF + 4);
                    *(f32x4*)(op + bj * HALF) = x0 + g0 * acc[ai][bj][m][0]; *(f32x4*)(op + bj * HALF + 4) = x1 + g1 * acc[ai][bj][m][1]; }
                if (m & 1) asm volatile("" ::: "memory"); }
    }
};
struct EpiRelu2 {
    static constexpr bool PERM = true, AFTER_DRAIN = false;
    bf16_t* O; int ldc;
    __device__ __forceinline__ void operator()(const f32x4 (&acc)[2][2][4][2], const Unit& u, int wr, int wc, int fr, int fq) const {
        const int col0 = u.pn * BM + wc * 32 + 8 * fq, row0 = u.pm * BM + wr * 64 + fr;
#pragma unroll
        for (int ai = 0; ai < 2; ++ai)
#pragma unroll
            for (int m = 0; m < 4; ++m) { bf16_t* rowp = O + (size_t)(row0 + ai * HALF + m * 16) * ldc + col0;
#pragma unroll
                for (int bj = 0; bj < 2; ++bj) { f32x4 v0 = acc[ai][bj][m][0], v1 = acc[ai][bj][m][1];
#pragma unroll
                    for (int e = 0; e < 4; ++e) { const float a = fmaxf(v0[e], 0.f), b = fmaxf(v1[e], 0.f); v0[e] = a * a; v1[e] = b * b; }
                    *(u32x4*)(rowp + bj * HALF) = pack8(v0, v1); } }
    }
};

struct EpiResGate2 {
    static constexpr bool PERM = true, AFTER_DRAIN = false;
    const float* res_p; const float* res_s; float* out; const float* gate; const float* sc2; const float* n2g; bf16_t* XN; float* rowss;
    __device__ __forceinline__ void operator()(const f32x4 (&acc)[2][2][4][2], const Unit& u, int wr, int wc, int fr, int fq) const {
        const int col0 = u.pn * BM + wc * 32 + 8 * fq, row0 = u.pm * BM + wr * 64 + fr;
#pragma unroll
        for (int ai = 0; ai < 2; ++ai)
#pragma unroll
            for (int m = 0; m < 4; ++m) { const int row = row0 + ai * HALF + m * 16;
                const int mrow = row < MP ? (row >> 13) : NB_P + ((row - MP) >> 5);
                const float* rp = (row < MP ? res_p + (size_t)row * DM : res_s + (size_t)(row - MP) * DM) + col0;
                const float* gp = gate + (size_t)mrow * (6 * DM) + col0; const float* cp = sc2 + (size_t)mrow * (6 * DM) + col0; float* op = out + (size_t)row * DM + col0;
                bf16_t* xp = XN + (size_t)row * DM + col0; float ss = 0.f;
#pragma unroll
                for (int bj = 0; bj < 2; ++bj) {
                    const f32x4 g0 = *(const f32x4*)(gp + bj * HALF), g1 = *(const f32x4*)(gp + bj * HALF + 4);
                    const f32x4 x0 = *(const f32x4*)(rp + bj * HALF), x1 = *(const f32x4*)(rp + bj * HALF + 4);
                    const f32x4 y0 = x0 + g0 * acc[ai][bj][m][0], y1 = x1 + g1 * acc[ai][bj][m][1];
                    *(f32x4*)(op + bj * HALF) = y0; *(f32x4*)(op + bj * HALF + 4) = y1;
                    ss += (y0[0] * y0[0] + y0[1] * y0[1]) + (y0[2] * y0[2] + y0[3] * y0[3]) + (y1[0] * y1[0] + y1[1] * y1[1]) + (y1[2] * y1[2] + y1[3] * y1[3]);
                    const f32x4 n0 = *(const f32x4*)(n2g + col0 + bj * HALF), n1 = *(const f32x4*)(n2g + col0 + bj * HALF + 4);
                    const f32x4 c0 = *(const f32x4*)(cp + bj * HALF), c1 = *(const f32x4*)(cp + bj * HALF + 4);
                    *(u32x4*)(xp + bj * HALF) = pack8(y0 * n0 * (c0 + 1.f), y1 * n1 * (c1 + 1.f)); }
                ss = fq_sum(ss);
                if (fq == 0) unsafeAtomicAdd(rowss + row, ss);
                asm volatile("" ::: "memory"); }
    }
};
struct EpiRelu2N {
    static constexpr bool PERM = true, AFTER_DRAIN = false;
    bf16_t* O; int ldc; const float* rowss; const float* bias2;
    __device__ __forceinline__ void operator()(const f32x4 (&acc)[2][2][4][2], const Unit& u, int wr, int wc, int fr, int fq) const {
        const int col0 = u.pn * BM + wc * 32 + 8 * fq, row0 = u.pm * BM + wr * 64 + fr;
#pragma unroll
        for (int ai = 0; ai < 2; ++ai)
#pragma unroll
            for (int m = 0; m < 4; ++m) { const int row = row0 + ai * HALF + m * 16; const int mrow = row < MP ? (row >> 13) : NB_P + ((row - MP) >> 5);
                const float rstd = 1.f / sqrtf(rowss[row] * (1.f / DM) + EPS);
                const float* bp = bias2 + (size_t)mrow * FF + col0; bf16_t* rowp = O + (size_t)row * ldc + col0;
#pragma unroll
                for (int bj = 0; bj < 2; ++bj) { f32x4 v0 = acc[ai][bj][m][0] * rstd + *(const f32x4*)(bp + bj * HALF), v1 = acc[ai][bj][m][1] * rstd + *(const f32x4*)(bp + bj * HALF + 4);
#pragma unroll
                    for (int e = 0; e < 4; ++e) { const float a = fmaxf(v0[e], 0.f), b = fmaxf(v1[e], 0.f); v0[e] = a * a; v1[e] = b * b; }
                    *(u32x4*)(rowp + bj * HALF) = pack8(v0, v1); } }
    }
};
struct EpiPartial {
    static constexpr bool PERM = true, AFTER_DRAIN = false;
    float* part; int ksz, nrows, ld;
    __device__ __forceinline__ void operator()(const f32x4 (&acc)[2][2][4][2], const Unit& u, int wr, int wc, int fr, int fq) const {
        const int col0 = u.pn * BM + wc * 32 + 8 * fq, row0 = u.pm * BM + wr * 64 + fr;
        float* pb = part + (size_t)(u.k0 / ksz) * nrows * ld;
#pragma unroll
        for (int ai = 0; ai < 2; ++ai)
#pragma unroll
            for (int m = 0; m < 4; ++m) { float* op = pb + (size_t)(row0 + ai * HALF + m * 16) * ld + col0;
#pragma unroll
                for (int bj = 0; bj < 2; ++bj) { *(f32x4*)(op + bj * HALF) = acc[ai][bj][m][0]; *(f32x4*)(op + bj * HALF + 4) = acc[ai][bj][m][1]; } }
    }
};

template <class Epi, class Sched, bool ALIGN_EPI = false, bool SP2 = false>
__device__ __forceinline__ void gemm_phase(PG8_LAS unsigned char* lds, const Gemm g, const Sched& S, const Epi& E) {
    int tid = threadIdx.x; asm volatile("" : "+v"(tid));
    const int wid = __builtin_amdgcn_readfirstlane(tid >> 6), lane = tid & 63, wr = wid >> 2, wc = wid & 3, fr = lane & 15, fq = lane >> 4;
    const int K = g.K, nt = (g.Kext ? g.Kext : K) / BK;
    unsigned voffA[2], voffB[2];
#pragma unroll
    for (int i = 0; i < 2; ++i) { int R, C; stage_rc(tid * 16 + i * 8192, R, C); const int Rb = Epi::PERM ? ((R & ~31) + perm32(R & 31)) : R;
        voffA[i] = (unsigned)(R * K + C) * 2u; voffB[i] = (unsigned)(Rb * K + C) * 2u; }
    const size_t kstep = (size_t)(BK * 2);
    const size_t hstep = (size_t)HALF * K * 2;
    const size_t tstep = 2 * hstep;
    const unsigned ldsw = (unsigned)wid * 1024u;
    const int aoff = lds_byte(wr * 64 + fr, fq * 8), boff = lds_byte(wc * 32 + fr, fq * 8);
#define PG8_SA(b, h) (((b) * 2 + (h)) * HTB)
#define PG8_SB(b, h) ((4 + (b) * 2 + (h)) * HTB)
#define PG8_STAGE(bufoff, gbase, voff) do { _Pragma("unroll") for (int _i = 0; _i < 2; ++_i) \
        __builtin_amdgcn_global_load_lds((const unsigned*)((const char*)(gbase) + (voff)[_i]), (PG8_LAS unsigned*)(lds + (bufoff) + ldsw + _i * 8192), 16, 0, 0); } while (0)
#define PG8_LDA(dst, b, h) do { _Pragma("unroll") for (int m = 0; m < 4; ++m) _Pragma("unroll") for (int k = 0; k < 2; ++k) dst[m][k] = *(const PG8_LAS bf16x8*)(lds + PG8_SA(b, h) + aoff + m * 2048 + k * 1024); } while (0)
#define PG8_LDB(dst, b, h) do { _Pragma("unroll") for (int n = 0; n < 2; ++n) _Pragma("unroll") for (int k = 0; k < 2; ++k) dst[n][k] = *(const PG8_LAS bf16x8*)(lds + PG8_SB(b, h) + boff + n * 2048 + k * 1024); } while (0)
#define PG8_MMA(ai, bj, At, Bt) do { __builtin_amdgcn_s_setprio(1); _Pragma("unroll") for (int m = 0; m < 4; ++m) _Pragma("unroll") for (int n = 0; n < 2; ++n) _Pragma("unroll") for (int k = 0; k < 2; ++k) \
        acc[ai][bj][m][n] = __builtin_amdgcn_mfma_f32_16x16x32_bf16(Bt[n][k], At[m][k], acc[ai][bj][m][n], 0, 0, 0); __builtin_amdgcn_s_setprio(0); } while (0)
#define PG8_WAIT_V(n) asm volatile("s_waitcnt vmcnt(" #n ")" ::: "memory")
#define PG8_WAIT_L(n) asm volatile("s_waitcnt lgkmcnt(" #n ")" ::: "memory")
#define PG8_BAR __builtin_amdgcn_s_barrier()
#define PG8_SCHED __builtin_amdgcn_sched_barrier(0)
    Unit cur, nxt; int ui = 0;
    if (!S.next(0, cur)) return;
    f32x4 acc[2][2][4][2];
#pragma unroll
    for (int a = 0; a < 2; ++a)
#pragma unroll
        for (int b = 0; b < 2; ++b)
#pragma unroll
            for (int m = 0; m < 4; ++m)
#pragma unroll
                for (int n = 0; n < 2; ++n) acc[a][b][m][n] = (f32x4){0.f, 0.f, 0.f, 0.f};
    bf16x8 At[4][2], B0[2][2], B1[2][2];
    const char* cA = (const char*)g.A + (size_t)cur.pm * tstep + (size_t)cur.k0 * 2; const char* cB = (const char*)g.Bt + (size_t)cur.pn * tstep + (size_t)cur.k0 * 2;
    S.a_ready(cur);
    if constexpr (SP2) {
        PG8_STAGE(PG8_SB(0, 0), cB, voffB); PG8_STAGE(PG8_SB(0, 1), cB + hstep, voffB); PG8_STAGE(PG8_SA(0, 0), cA, voffA); PG8_STAGE(PG8_SA(0, 1), cA + hstep, voffA);
        if (wr == 1) PG8_BAR;
        PG8_WAIT_V(2); PG8_BAR;
        PG8_STAGE(PG8_SB(1, 0), cB + kstep, voffB); PG8_STAGE(PG8_SA(1, 0), cA + kstep, voffA); PG8_STAGE(PG8_SB(1, 1), cB + hstep + kstep, voffB);
        PG8_WAIT_V(6); PG8_BAR;
    } else {
        PG8_STAGE(PG8_SB(0, 0), cB, voffB); PG8_STAGE(PG8_SA(0, 0), cA, voffA); PG8_STAGE(PG8_SB(0, 1), cB + hstep, voffB); PG8_STAGE(PG8_SA(0, 1), cA + hstep, voffA);
        if (wr == 1) PG8_BAR;
        PG8_WAIT_V(4); PG8_BAR;
        PG8_STAGE(PG8_SB(1, 0), cB + kstep, voffB); PG8_STAGE(PG8_SA(1, 0), cA + kstep, voffA); PG8_STAGE(PG8_SB(1, 1), cB + hstep + kstep, voffB);
        PG8_WAIT_V(6); PG8_BAR;
    }
    for (;;) {
        const bool has_next = S.next(ui + 1, nxt);
        const char* nA = has_next ? (const char*)g.A + (size_t)nxt.pm * tstep + (size_t)nxt.k0 * 2 : cA; const char* nB = has_next ? (const char*)g.Bt + (size_t)nxt.pn * tstep + (size_t)nxt.k0 * 2 : cB;
        for (int t = 0; t < nt; t += 2) {
            const bool last = (t == nt - 2);
            const char* a1 = cA + (size_t)(t + 1) * kstep;
            const char* a2 = last ? nA : cA + (size_t)(t + 2) * kstep; const char* b2 = last ? nB : cB + (size_t)(t + 2) * kstep;
            const char* a3 = a2 + kstep; const char* b3 = b2 + kstep;
            if (last && has_next) S.a_ready(nxt);
            if constexpr (SP2) {
            PG8_LDB(B0, 0, 0); PG8_LDB(B1, 0, 1); PG8_SCHED; PG8_LDA(At, 0, 0); PG8_STAGE(PG8_SA(1, 1), a1 + hstep, voffA);
            PG8_WAIT_V(8); PG8_WAIT_L(0); PG8_BAR; PG8_MMA(0, 0, At, B0); PG8_MMA(0, 1, At, B1); PG8_BAR; PG8_SCHED;
            PG8_LDA(At, 0, 1); PG8_STAGE(PG8_SB(0, 0), b2, voffB); PG8_STAGE(PG8_SB(0, 1), b2 + hstep, voffB); PG8_STAGE(PG8_SA(0, 0), a2, voffA);
            PG8_WAIT_V(8); PG8_WAIT_L(0); PG8_BAR; PG8_MMA(1, 0, At, B0); PG8_MMA(1, 1, At, B1); PG8_BAR; PG8_SCHED;
            PG8_LDB(B0, 1, 0); PG8_LDB(B1, 1, 1); PG8_SCHED; PG8_LDA(At, 1, 0); PG8_STAGE(PG8_SA(0, 1), a2 + hstep, voffA);
            PG8_WAIT_V(8); PG8_WAIT_L(0); PG8_BAR; PG8_MMA(0, 0, At, B0); PG8_MMA(0, 1, At, B1); PG8_BAR; PG8_SCHED;
            PG8_LDA(At, 1, 1); PG8_STAGE(PG8_SB(1, 0), b3, voffB); PG8_STAGE(PG8_SB(1, 1), b3 + hstep, voffB); PG8_STAGE(PG8_SA(1, 0), a3, voffA);
            PG8_WAIT_V(8); PG8_WAIT_L(0); PG8_BAR; PG8_MMA(1, 0, At, B0); PG8_MMA(1, 1, At, B1); PG8_BAR; PG8_SCHED;
            } else {
            PG8_LDB(B0, 0, 0); PG8_SCHED; PG8_LDA(At, 0, 0); PG8_STAGE(PG8_SA(1, 1), a1 + hstep, voffA);
            PG8_WAIT_L(8); PG8_BAR; PG8_WAIT_L(0); PG8_MMA(0, 0, At, B0); PG8_BAR; PG8_SCHED;
            PG8_LDB(B1, 0, 1); PG8_STAGE(PG8_SB(0, 0), b2, voffB);
            PG8_BAR; PG8_WAIT_L(0); PG8_MMA(0, 1, At, B1); PG8_BAR;
            PG8_LDA(At, 0, 1); PG8_STAGE(PG8_SA(0, 0), a2, voffA);
            PG8_BAR; PG8_WAIT_L(0); PG8_MMA(1, 0, At, B0); PG8_BAR; PG8_SCHED;
            PG8_STAGE(PG8_SB(0, 1), b2 + hstep, voffB);
            PG8_WAIT_V(6); PG8_BAR; PG8_MMA(1, 1, At, B1); PG8_BAR;
            PG8_LDB(B0, 1, 0); PG8_SCHED; PG8_LDA(At, 1, 0); PG8_STAGE(PG8_SA(0, 1), a2 + hstep, voffA);
            PG8_WAIT_L(8); PG8_BAR; PG8_WAIT_L(0); PG8_MMA(0, 0, At, B0); PG8_BAR; PG8_SCHED;
            PG8_LDB(B1, 1, 1); PG8_STAGE(PG8_SB(1, 0), b3, voffB);
            PG8_BAR; PG8_WAIT_L(0); PG8_MMA(0, 1, At, B1); PG8_BAR;
            PG8_LDA(At, 1, 1); PG8_STAGE(PG8_SA(1, 0), a3, voffA);
            PG8_BAR; PG8_WAIT_L(0); PG8_MMA(1, 0, At, B0); PG8_BAR; PG8_SCHED;
            PG8_STAGE(PG8_SB(1, 1), b3 + hstep, voffB);
            PG8_WAIT_V(6); PG8_BAR; PG8_MMA(1, 1, At, B1); PG8_BAR;
            }
        }
        if constexpr (ALIGN_EPI) { if (wr == 0) PG8_BAR; }
        if constexpr (!Epi::AFTER_DRAIN) { E(acc, cur, wr, wc, fr, fq); S.done(cur); }
        if (!has_next) break;
#pragma unroll
        for (int a = 0; a < 2; ++a)
#pragma unroll
            for (int b = 0; b < 2; ++b)
#pragma unroll
                for (int m = 0; m < 4; ++m)
#pragma unroll
                    for (int n = 0; n < 2; ++n) acc[a][b][m][n] = (f32x4){0.f, 0.f, 0.f, 0.f};
        cur = nxt; cA = nA; cB = nB; ++ui;
        if constexpr (ALIGN_EPI) { if (wr == 1) PG8_BAR; }
    }
    PG8_WAIT_V(0);
    if constexpr (!ALIGN_EPI) { if (wr == 0) PG8_BAR; }
    PG8_BAR;
    if constexpr (Epi::AFTER_DRAIN) { E.fused(acc, cur, wr, wc, fr, fq, lds, wid, lane); S.done(cur); }
#undef PG8_SA
#undef PG8_SB
#undef PG8_STAGE
#undef PG8_LDA
#undef PG8_LDB
#undef PG8_MMA
#undef PG8_WAIT_V
#undef PG8_WAIT_L
#undef PG8_BAR
#undef PG8_SCHED
}
}

namespace att {
#define ALAS __attribute__((address_space(3)))
typedef unsigned short bf16_t;
typedef short bf16x8 __attribute__((ext_vector_type(8)));
typedef short s16x4 __attribute__((ext_vector_type(4)));
typedef float f32x16 __attribute__((ext_vector_type(16)));
typedef float f32x4 __attribute__((ext_vector_type(4)));
typedef float f32x2_t __attribute__((ext_vector_type(2)));
typedef __bf16 bf16x2_t __attribute__((ext_vector_type(2)));
typedef unsigned u32x4 __attribute__((ext_vector_type(4)));
typedef unsigned u32x2 __attribute__((ext_vector_type(2)));
typedef short v4i16_t __attribute__((ext_vector_type(4)));
constexpr int TILE_B = 16384;
constexpr int STG_K = 0, STG_V = 2 * TILE_B, STG_B = 4 * TILE_B;
__device__ __forceinline__ int crow(int r, int h) { return (r & 3) + 8 * (r >> 2) + 4 * h; }
__device__ __forceinline__ unsigned cvtpk(float lo, float hi) { f32x2_t v = {lo, hi}; bf16x2_t b = __builtin_convertvector(v, bf16x2_t); return __builtin_bit_cast(unsigned, b); }
__device__ __forceinline__ float half_max(float v) { auto rr = __builtin_amdgcn_permlane32_swap(__float_as_uint(v), __float_as_uint(v), false, false); return fmaxf(__uint_as_float(rr[0]), __uint_as_float(rr[1])); }
__device__ __forceinline__ float half_sum(float v) { auto rr = __builtin_amdgcn_permlane32_swap(__float_as_uint(v), __float_as_uint(v), false, false); return __uint_as_float(rr[0]) + __uint_as_float(rr[1]); }
__device__ __forceinline__ s16x4 vtr(const ALAS unsigned char* p) { return __builtin_bit_cast(s16x4, __builtin_amdgcn_ds_read_tr16_b64_v4i16((ALAS v4i16_t*)p)); }

struct UnitDesc { const bf16_t* Q; const bf16_t* K; const bf16_t* V; bf16_t* O; int q0pos, nvalid, kv_len, s_hi, s_lo; float slope2; };

__device__ __forceinline__ void attn_unit(ALAS unsigned char* lds, const UnitDesc d, const float lam, const float* __restrict__ subg) {
    int tid = threadIdx.x; asm volatile("" : "+v"(tid));
    const int lane = tid & 63, w = __builtin_amdgcn_readfirstlane(tid >> 6), c = w >> 2, j = w & 3, r32 = lane & 31, hh = lane >> 5;
    const bool active = (32 * j < d.nvalid);
    const int qw0 = d.q0pos + 32 * j;
    const int td = active ? (qw0 >> 6) : -1;
    const int lrow = lane >> 4; const unsigned fsw = (((unsigned)lrow & 3u) << 2) | ((unsigned)w & 3u); const int gch = (int)(((unsigned)lane & 15u) ^ fsw);
    const bf16_t* kg = d.K + (size_t)(4 * w + lrow) * HW + gch * 8;
    const bf16_t* vg = d.V + (size_t)(4 * w + lrow) * HW + gch * 8;
#define ATT_DMA(s_, buf_) do { const size_t go_ = (size_t)(s_) * 128 * HW; ALAS unsigned char* lb_ = lds + (buf_) * STG_B + w * 1024; \
        _Pragma("unroll") for (int i_ = 0; i_ < 4; ++i_) { \
        __builtin_amdgcn_global_load_lds((const unsigned*)(kg + go_ + (size_t)i_ * 32 * HW), (ALAS unsigned*)(lb_ + STG_K + i_ * 8192), 16, 0, 0); \
        __builtin_amdgcn_global_load_lds((const unsigned*)(vg + go_ + (size_t)i_ * 32 * HW), (ALAS unsigned*)(lb_ + STG_V + i_ * 8192), 16, 0, 0); } } while (0)
    bf16x8 qf[4];
#pragma unroll
    for (int s = 0; s < 4; ++s) { if (active) qf[s] = *(const bf16x8*)(d.Q + (size_t)(32 * j + r32) * HW + c * 64 + 16 * s + 8 * hh); else qf[s] = (bf16x8){0, 0, 0, 0, 0, 0, 0, 0}; }
    unsigned koff[4];
    { const unsigned f = ((r32 & 3u) << 2) | ((r32 >> 2) & 3u);
#pragma unroll
      for (int s = 0; s < 4; ++s) koff[s] = 256u * r32 + 16u * (((unsigned)(8 * c + 2 * s + hh)) ^ f); }
    unsigned voff[2][4];
    { const unsigned qq = (lane & 15) >> 2, p = lane & 3, blk = (lane >> 4) & 1;
#pragma unroll
      for (int tt = 0; tt < 2; ++tt)
#pragma unroll
          for (int c4 = 0; c4 < 4; ++c4)
              voff[tt][c4] = 256u * (8 * tt + 4 * hh + qq) + 16u * ((((unsigned)c4 ^ qq) << 2) | (((2 * blk + (p >> 1)) ^ (unsigned)(2 * tt + hh)) & 3u)) + 8u * (p & 1); }
    float mref = 0.f, lsum = 0.f;
    f32x16 o[4];
#pragma unroll
    for (int c4 = 0; c4 < 4; ++c4)
#pragma unroll
        for (int i = 0; i < 16; ++i) o[c4][i] = 0.f;

    const int NI = d.s_hi - d.s_lo + 1;
    ATT_DMA(d.s_lo, 0);
    for (int it = 0; it + 1 < NI; ++it) {
        const int sg = d.s_lo + it;
        asm volatile("s_waitcnt vmcnt(0)" ::: "memory"); __syncthreads();
        ATT_DMA(sg + 1, (it + 1) & 1);
        const ALAS unsigned char* Sb = lds + (it & 1) * STG_B;
#define ATT_SB() __builtin_amdgcn_sched_barrier(0)
#define ATT_KLD(Kb_) do { _Pragma("unroll") for (int s = 0; s < 4; ++s) { kf[2 * s] = *(const ALAS bf16x8*)((Kb_) + koff[s]); kf[2 * s + 1] = *(const ALAS bf16x8*)((Kb_) + koff[s] + 8192); } } while (0)
#define ATT_QK(x0_, x1_) do { _Pragma("unroll") for (int s = 0; s < 4; ++s) { x0_ = __builtin_amdgcn_mfma_f32_32x32x16_bf16(kf[2 * s], qf[s], x0_, 0, 0, 0); x1_ = __builtin_amdgcn_mfma_f32_32x32x16_bf16(kf[2 * s + 1], qf[s], x1_, 0, 0, 0); } } while (0)
#define ATT_VLD2(bsel_, Vb_, ks_) do { _Pragma("unroll") for (int c4 = 0; c4 < 4; ++c4) { vl[bsel_][c4] = vtr((Vb_) + voff[0][c4] + 4096 * (ks_)); vh[bsel_][c4] = vtr((Vb_) + voff[1][c4] + 4096 * (ks_)); } } while (0)
#define ATT_PVK(ks_, pf_) do { _Pragma("unroll") for (int c4 = 0; c4 < 4; ++c4) { const s16x4 lo = vl[(ks_) & 1][c4], hi = vh[(ks_) & 1][c4]; \
            const bf16x8 vt = (bf16x8){lo[0], lo[1], lo[2], lo[3], hi[0], hi[1], hi[2], hi[3]}; o[c4] = __builtin_amdgcn_mfma_f32_32x32x16_bf16(vt, pf_[ks_], o[c4], 0, 0, 0); } } while (0)
#define ATT_SOFTMAX(x0_, x1_, pf_) do { float ps_ = 0.f; \
            _Pragma("unroll") for (int i = 0; i < 16; ++i) { x0_[i] = __builtin_amdgcn_exp2f(x0_[i]); x1_[i] = __builtin_amdgcn_exp2f(x1_[i]); } \
            _Pragma("unroll") for (int i = 0; i < 16; i += 2) pm = fmaxf(fmaxf(pm, fmaxf(x0_[i], x0_[i + 1])), fmaxf(x1_[i], x1_[i + 1])); \
            _Pragma("unroll") for (int i = 0; i < 16; ++i) ps_ += x0_[i] + x1_[i]; \
            lsum += ps_; \
            _Pragma("unroll") for (int s = 0; s < 2; ++s) { u32x4 a_, b_; \
                a_.x = cvtpk(x0_[8 * s], x0_[8 * s + 1]); a_.y = cvtpk(x0_[8 * s + 2], x0_[8 * s + 3]); a_.z = cvtpk(x0_[8 * s + 4], x0_[8 * s + 5]); a_.w = cvtpk(x0_[8 * s + 6], x0_[8 * s + 7]); \
                b_.x = cvtpk(x1_[8 * s], x1_[8 * s + 1]); b_.y = cvtpk(x1_[8 * s + 2], x1_[8 * s + 3]); b_.z = cvtpk(x1_[8 * s + 4], x1_[8 * s + 5]); b_.w = cvtpk(x1_[8 * s + 6], x1_[8 * s + 7]); \
                pf_[s] = __builtin_bit_cast(bf16x8, a_); pf_[2 + s] = __builtin_bit_cast(bf16x8, b_); } } while (0)
        if (active) {
            const ALAS unsigned char* K0 = Sb + STG_K; const ALAS unsigned char* V0 = Sb + STG_V;
            f32x16 a0, a1, b0, b1;
            { const float c0 = d.slope2 * (float)(128 * sg - qw0 + 4 * hh) - mref, st = 32.f * d.slope2;
#pragma unroll
              for (int i = 0; i < 16; ++i) { const float ci = (float)((i & 3) + 8 * (i >> 2));
                  a0[i] = __builtin_fmaf(d.slope2, ci, c0); a1[i] = __builtin_fmaf(d.slope2, ci, c0 + st); b0[i] = __builtin_fmaf(d.slope2, ci, c0 + 2.f * st); b1[i] = __builtin_fmaf(d.slope2, ci, c0 + 3.f * st); } }
            bf16x8 kf[8]; s16x4 vl[2][4], vh[2][4]; bf16x8 pfA[4], pfB[4]; float pm = 0.f;
            ATT_KLD(K0); ATT_SB();
            ATT_QK(a0, a1);
            ATT_KLD(K0 + TILE_B); ATT_SB();
            ATT_QK(b0, b1);
            ATT_SOFTMAX(a0, a1, pfA);
#pragma unroll
            for (int g = 0; g < 8; ++g) { __builtin_amdgcn_sched_group_barrier(0x008, 1, 0); __builtin_amdgcn_sched_group_barrier(0x400, 4, 0); __builtin_amdgcn_sched_group_barrier(0x002, 9, 0); }
            ATT_SB();
            ATT_VLD2(0, V0, 0); ATT_VLD2(1, V0, 1); ATT_SB();
            float psB = 0.f;
#define ATT_SM_CHUNK(k_) do { _Pragma("unroll") for (int i = 4 * (k_); i < 4 * (k_) + 4; ++i) { b0[i] = __builtin_amdgcn_exp2f(b0[i]); b1[i] = __builtin_amdgcn_exp2f(b1[i]); } \
            pm = fmaxf(fmaxf(pm, fmaxf(b0[4 * (k_)], b0[4 * (k_) + 1])), fmaxf(b0[4 * (k_) + 2], b0[4 * (k_) + 3])); pm = fmaxf(fmaxf(pm, fmaxf(b1[4 * (k_)], b1[4 * (k_) + 1])), fmaxf(b1[4 * (k_) + 2], b1[4 * (k_) + 3])); \
            psB += (b0[4 * (k_)] + b0[4 * (k_) + 1]) + (b0[4 * (k_) + 2] + b0[4 * (k_) + 3]) + (b1[4 * (k_)] + b1[4 * (k_) + 1]) + (b1[4 * (k_) + 2] + b1[4 * (k_) + 3]); } while (0)
#define ATT_PIPE4() do { _Pragma("unroll") for (int g = 0; g < 4; ++g) { __builtin_amdgcn_sched_group_barrier(0x008, 1, 2); __builtin_amdgcn_sched_group_barrier(0x400, 2, 2); __builtin_amdgcn_sched_group_barrier(0x002, 4, 2); } } while (0)
            ATT_PVK(0, pfA); ATT_SM_CHUNK(0); ATT_VLD2(0, V0, 2); ATT_PIPE4(); ATT_SB();
            ATT_PVK(1, pfA); ATT_SM_CHUNK(1); ATT_VLD2(1, V0, 3); ATT_PIPE4(); ATT_SB();
            ATT_PVK(2, pfA); ATT_SM_CHUNK(2); ATT_VLD2(0, V0 + TILE_B, 0); ATT_PIPE4(); ATT_SB();
            ATT_PVK(3, pfA); ATT_SM_CHUNK(3); ATT_VLD2(1, V0 + TILE_B, 1);
            lsum += psB;
#pragma unroll
            for (int s2 = 0; s2 < 2; ++s2) { u32x4 a_, b_;
                a_.x = cvtpk(b0[8 * s2], b0[8 * s2 + 1]); a_.y = cvtpk(b0[8 * s2 + 2], b0[8 * s2 + 3]); a_.z = cvtpk(b0[8 * s2 + 4], b0[8 * s2 + 5]); a_.w = cvtpk(b0[8 * s2 + 6], b0[8 * s2 + 7]);
                b_.x = cvtpk(b1[8 * s2], b1[8 * s2 + 1]); b_.y = cvtpk(b1[8 * s2 + 2], b1[8 * s2 + 3]); b_.z = cvtpk(b1[8 * s2 + 4], b1[8 * s2 + 5]); b_.w = cvtpk(b1[8 * s2 + 6], b1[8 * s2 + 7]);
                pfB[s2] = __builtin_bit_cast(bf16x8, a_); pfB[2 + s2] = __builtin_bit_cast(bf16x8, b_); }
#pragma unroll
            for (int g = 0; g < 4; ++g) { __builtin_amdgcn_sched_group_barrier(0x008, 1, 3); __builtin_amdgcn_sched_group_barrier(0x400, 2, 3); __builtin_amdgcn_sched_group_barrier(0x002, 8, 3); }
            ATT_SB();
            ATT_PVK(0, pfB); ATT_VLD2(0, V0 + TILE_B, 2); ATT_SB();
            ATT_PVK(1, pfB); ATT_VLD2(1, V0 + TILE_B, 3); ATT_SB();
            ATT_PVK(2, pfB);
            ATT_PVK(3, pfB);
            ATT_SB();
#undef ATT_SM_CHUNK
#undef ATT_PIPE4
            if (__builtin_expect(__any(pm > 256.f), 0)) {
                pm = half_max(pm);
                const float dl = pm > 1.f ? ceilf(__builtin_amdgcn_logf(pm)) : 0.f, f = __builtin_amdgcn_exp2f(-dl);
                mref += dl; lsum *= f;
#pragma unroll
                for (int c4 = 0; c4 < 4; ++c4)
#pragma unroll
                    for (int i = 0; i < 16; ++i) o[c4][i] *= f;
            }
        }
    }
    {
        const int it = NI - 1, sg = d.s_hi;
        asm volatile("s_waitcnt vmcnt(0)" ::: "memory"); __syncthreads();
        const ALAS unsigned char* Sb = lds + (it & 1) * STG_B;
#pragma unroll
        for (int tau = 0; tau < 2; ++tau) {
            const int t = 2 * sg + tau;
            if (t <= td) {
                const ALAS unsigned char* Kb = Sb + STG_K + tau * TILE_B; const ALAS unsigned char* Vb = Sb + STG_V + tau * TILE_B;
                f32x16 s0, s1;
                if (t == td) {
                    const int qpos = qw0 + r32; const float rc = d.slope2 * (float)r32 - mref;
#pragma unroll
                    for (int i = 0; i < 16; ++i) { const int k0 = 64 * t + crow(i, hh), k1 = k0 + 32;
                        const int d0 = qpos - k0, d1 = qpos - k1;
                        s0[i] = k0 < d.kv_len ? rc - d.slope2 * (float)(d0 < 0 ? -d0 : d0) : -1e30f;
                        s1[i] = k1 < d.kv_len ? rc - d.slope2 * (float)(d1 < 0 ? -d1 : d1) : -1e30f; }
                } else {
                    const float b0 = d.slope2 * (float)(64 * t - qw0 + 4 * hh) - mref, b1 = b0 + 32.f * d.slope2;
#pragma unroll
                    for (int i = 0; i < 16; ++i) { const float ci = (float)((i & 3) + 8 * (i >> 2)); s0[i] = __builtin_fmaf(d.slope2, ci, b0); s1[i] = __builtin_fmaf(d.slope2, ci, b1); }
                }
                bf16x8 kf[8];
#pragma unroll
                for (int s = 0; s < 4; ++s) { kf[2 * s] = *(const ALAS bf16x8*)(Kb + koff[s]); kf[2 * s + 1] = *(const ALAS bf16x8*)(Kb + koff[s] + 8192); }
                __builtin_amdgcn_sched_barrier(0);
#pragma unroll
                for (int s = 0; s < 4; ++s) {
                    s0 = __builtin_amdgcn_mfma_f32_32x32x16_bf16(kf[2 * s], qf[s], s0, 0, 0, 0);
                    s1 = __builtin_amdgcn_mfma_f32_32x32x16_bf16(kf[2 * s + 1], qf[s], s1, 0, 0, 0);
                }
                s16x4 vl[2][4], vh[2][4];
#define ATT_VLD(bsel_, ks_) do { _Pragma("unroll") for (int c4 = 0; c4 < 4; ++c4) { vl[bsel_][c4] = vtr(Vb + voff[0][c4] + 4096 * (ks_)); vh[bsel_][c4] = vtr(Vb + voff[1][c4] + 4096 * (ks_)); } } while (0)
                ATT_VLD(0, 0);
                __builtin_amdgcn_sched_barrier(0);
                float pm = 0.f, ps = 0.f;
#pragma unroll
                for (int i = 0; i < 16; ++i) { s0[i] = __builtin_amdgcn_exp2f(s0[i]); s1[i] = __builtin_amdgcn_exp2f(s1[i]); }
#pragma unroll
                for (int i = 0; i < 16; i += 2) pm = fmaxf(fmaxf(pm, fmaxf(s0[i], s0[i + 1])), fmaxf(s1[i], s1[i + 1]));
                if (__builtin_expect(__any(pm > 256.f), 0)) {
                    pm = half_max(pm);
                    const float dl = pm > 1.f ? ceilf(__builtin_amdgcn_logf(pm)) : 0.f, f = __builtin_amdgcn_exp2f(-dl);
                    mref += dl; lsum *= f;
#pragma unroll
                    for (int i = 0; i < 16; ++i) { s0[i] *= f; s1[i] *= f; }
#pragma unroll
                    for (int c4 = 0; c4 < 4; ++c4)
#pragma unroll
                        for (int i = 0; i < 16; ++i) o[c4][i] *= f;
                }
#pragma unroll
                for (int i = 0; i < 16; ++i) ps += s0[i] + s1[i];
                lsum += ps;
                bf16x8 pf[4];
#pragma unroll
                for (int s = 0; s < 2; ++s) {
                    u32x4 a, b;
                    a.x = cvtpk(s0[8 * s], s0[8 * s + 1]); a.y = cvtpk(s0[8 * s + 2], s0[8 * s + 3]); a.z = cvtpk(s0[8 * s + 4], s0[8 * s + 5]); a.w = cvtpk(s0[8 * s + 6], s0[8 * s + 7]);
                    b.x = cvtpk(s1[8 * s], s1[8 * s + 1]); b.y = cvtpk(s1[8 * s + 2], s1[8 * s + 3]); b.z = cvtpk(s1[8 * s + 4], s1[8 * s + 5]); b.w = cvtpk(s1[8 * s + 6], s1[8 * s + 7]);
                    pf[s] = __builtin_bit_cast(bf16x8, a); pf[2 + s] = __builtin_bit_cast(bf16x8, b);
                }
#pragma unroll
                for (int ks = 0; ks < 4; ++ks) {
                    if (ks < 3) ATT_VLD((ks + 1) & 1, ks + 1);
                    __builtin_amdgcn_sched_barrier(0);
#pragma unroll
                    for (int c4 = 0; c4 < 4; ++c4) {
                        const s16x4 lo = vl[ks & 1][c4], hi = vh[ks & 1][c4];
                        const bf16x8 vt = (bf16x8){lo[0], lo[1], lo[2], lo[3], hi[0], hi[1], hi[2], hi[3]};
                        o[c4] = __builtin_amdgcn_mfma_f32_32x32x16_bf16(vt, pf[ks], o[c4], 0, 0, 0);
                    }
                    __builtin_amdgcn_sched_barrier(0);
                }
#undef ATT_VLD
            }
        }
    }
    __syncthreads();
    const float ltot = half_sum(lsum), inv = active ? 1.f / ltot : 0.f;
    ALAS float* xch = (ALAS float*)lds + j * 4096;
    if (c == 1 && active) {
#pragma unroll
        for (int c4 = 0; c4 < 4; ++c4)
#pragma unroll
            for (int i = 0; i < 16; ++i) xch[(c4 * 16 + i) * 64 + lane] = o[c4][i] * inv;
    }
    __syncthreads();
    if (c == 0 && active) {
        float ss = 0.f;
#pragma unroll
        for (int c4 = 0; c4 < 4; ++c4)
#pragma unroll
            for (int i = 0; i < 16; ++i) { const float v = o[c4][i] * inv - lam * xch[(c4 * 16 + i) * 64 + lane]; o[c4][i] = v; ss += v * v; }
        ss = half_sum(ss);
        const float rs = 0.8f / sqrtf(ss * (1.f / 128.f) + EPS);
        bf16_t* op = d.O + (size_t)(32 * j + r32) * DM + 4 * hh;
#pragma unroll
        for (int c4 = 0; c4 < 4; ++c4)
#pragma unroll
            for (int g4 = 0; g4 < 4; ++g4) { const int dv0 = 32 * c4 + 8 * g4;
                const f32x4 g = *(const f32x4*)(subg + dv0 + 4 * hh);
                u32x2 pk; pk.x = cvtpk(o[c4][4 * g4] * rs * g[0], o[c4][4 * g4 + 1] * rs * g[1]); pk.y = cvtpk(o[c4][4 * g4 + 2] * rs * g[2], o[c4][4 * g4 + 3] * rs * g[3]);
                *(u32x2*)(op + dv0) = pk; }
    }
    __syncthreads();
}
#undef ATT_DMA
#undef ATT_SB
#undef ATT_KLD
#undef ATT_QK
#undef ATT_VLD2
#undef ATT_PVK
#undef ATT_SOFTMAX
#undef ALAS
}

#define GAS __attribute__((address_space(1)))
#define LAS __attribute__((address_space(3)))
typedef unsigned short bf16;
typedef unsigned v4u __attribute__((ext_vector_type(4)));
typedef unsigned v2u __attribute__((ext_vector_type(2)));
typedef float f32x4 __attribute__((ext_vector_type(4)));
constexpr int NWAVES = 8, NTHREADS = 512;
constexpr int LDS_BYTES = 147456;
constexpr size_t MiB = 1u << 20;
constexpr size_t WS_MOD = 0;
constexpr size_t WS_QCTR = 1 * MiB + 16384, WS_MAXB = 1 * MiB + 32768;
constexpr size_t WS_BAR = 1 * MiB;
constexpr size_t WS_ROWSS = 1 * MiB + 65536;
constexpr size_t WS_SH2 = 30 * MiB;
constexpr size_t WS_BIAS2 = 26 * MiB;
constexpr size_t CTL_BYTES = 65536 + (size_t)MT * 4;
constexpr int MISC_OFF = 131072 + 320;
constexpr size_t WS_WIN = 2 * MiB, WS_WO = 8 * MiB, WS_W1 = 10 * MiB, WS_W2 = 18 * MiB;
constexpr size_t WS_XN = 32 * MiB;
constexpr size_t WS_HB = 192 * MiB;
constexpr size_t WS_BG = 192 * MiB, WS_CG = 257 * MiB, WS_UG = 322 * MiB, WS_QB = 387 * MiB;
constexpr size_t WS_KB = 452 * MiB, WS_VB = 550 * MiB;
constexpr size_t WS_MIX = 648 * MiB;
constexpr size_t WS_END = 778 * MiB;
static_assert((size_t)MT * HW * 2 <= 65 * MiB && (size_t)KVROWS * HW * 2 <= 98 * MiB && (size_t)MT * DM * 2 <= 130 * MiB && (size_t)MT * FF * 2 <= 520 * MiB, "ws map");

__device__ __forceinline__ unsigned f2bf(float f) { unsigned u = __builtin_bit_cast(unsigned, f); return (u + 0x7fffu + ((u >> 16) & 1u)) >> 16; }
__device__ __forceinline__ unsigned pk2(float lo, float hi) { return f2bf(lo) | (f2bf(hi) << 16); }
__device__ __forceinline__ float bflo(unsigned u) { return __builtin_bit_cast(float, u << 16); }
__device__ __forceinline__ float bfhi(unsigned u) { return __builtin_bit_cast(float, u & 0xffff0000u); }
__device__ __forceinline__ float wave_sum(float v) {
    v += __builtin_bit_cast(float, __builtin_amdgcn_update_dpp(0, __builtin_bit_cast(int, v), 0xB1, 0xf, 0xf, true));
    v += __builtin_bit_cast(float, __builtin_amdgcn_update_dpp(0, __builtin_bit_cast(int, v), 0x4E, 0xf, 0xf, true));
    v += __builtin_bit_cast(float, __builtin_amdgcn_update_dpp(0, __builtin_bit_cast(int, v), 0x141, 0xf, 0xf, true));
    v += __builtin_bit_cast(float, __builtin_amdgcn_update_dpp(0, __builtin_bit_cast(int, v), 0x140, 0xf, 0xf, true));
    { auto r = __builtin_amdgcn_permlane16_swap(__float_as_uint(v), __float_as_uint(v), false, false); v = __uint_as_float(r[0]) + __uint_as_float(r[1]); }
    { auto r = __builtin_amdgcn_permlane32_swap(__float_as_uint(v), __float_as_uint(v), false, false); v = __uint_as_float(r[0]) + __uint_as_float(r[1]); }
    return v;
}
#define LDS_WAIT() asm volatile("s_waitcnt lgkmcnt(0)" ::: "memory")

#define XB_TMO      128
#define XB_XCNT(j)  (256  + 64 * (j))
#define XB_XSUB(j)  (1280 + 64 * (j))
#define XB_XGEN(j)  (2304 + 64 * (j))
#define XB_TOP      3328
#define XB_TOPGEN   3392
#define XCD_BAR_WORDS 3456
#define XB_SPIN_CAP (1u << 18)

__device__ __forceinline__ unsigned xb_ld(unsigned* p)              { return __hip_atomic_load(p, __ATOMIC_RELAXED, __HIP_MEMORY_SCOPE_AGENT); }
__device__ __forceinline__ unsigned xb_add(unsigned* p, unsigned v) { return __hip_atomic_fetch_add(p, v, __ATOMIC_RELAXED, __HIP_MEMORY_SCOPE_AGENT); }
__device__ __forceinline__ unsigned xb_xcc_id() { return (unsigned)__builtin_amdgcn_s_getreg((3 << 11) | 20) & 0xFu; }
#define XB_SPIN(cond, bar) do { unsigned _sp = 0; while (cond) { __builtin_amdgcn_s_sleep(1); \
    if ((++_sp & 255u) == 0u) { if (xb_ld(&(bar)[XB_TMO])) break; if (_sp > XB_SPIN_CAP) { atomicAdd(&(bar)[XB_TMO], 1u); break; } } } } while (0)

struct XcdBarrier {
    unsigned* bar; unsigned x;
    volatile LAS unsigned* st;
};

__device__ __forceinline__ XcdBarrier xcd_barrier_post(unsigned* bar, volatile LAS unsigned* st) {
    XcdBarrier b; b.bar = bar; b.x = xb_xcc_id(); b.st = st;
    if (threadIdx.x == 0) (void)xb_add(&bar[XB_XCNT(b.x)], 1u);
    return b;
}
__device__ __forceinline__ void xcd_barrier_complete(unsigned* bar, unsigned x, unsigned& nloc, unsigned& nx) {
    const unsigned G = gridDim.x * gridDim.y * gridDim.z;
    unsigned sum, cnt, mine, sp = 0u;
    for (;;) {
        sum = 0u; cnt = 0u; mine = 0u;
#pragma unroll
        for (unsigned j = 0; j < 16; ++j) { const unsigned c = xb_ld(&bar[XB_XCNT(j)]); sum += c; cnt += (c > 0u) ? 1u : 0u; mine = (j == x) ? c : mine; }
        if (sum == G) break;
        __builtin_amdgcn_s_sleep(1);
        if ((++sp & 255u) == 0u) { if (xb_ld(&bar[XB_TMO])) break; if (sp > XB_SPIN_CAP) { atomicAdd(&bar[XB_TMO], 1u); break; } }
    }
    nloc = mine > 0u ? mine : 1u; nx = cnt > 0u ? cnt : 1u;
}

__device__ __forceinline__ void xcd_barrier(const XcdBarrier& b) {
    asm volatile("s_waitcnt vmcnt(0)" ::: "memory");
    __syncthreads();
    if (threadIdx.x == 0) {
        unsigned* bar = b.bar;
        __builtin_amdgcn_s_waitcnt(0);
        unsigned nloc = b.st[0], nx = b.st[1];
        if (nloc == 0u) { xcd_barrier_complete(bar, b.x, nloc, nx); b.st[0] = nloc; b.st[1] = nx; }
        const unsigned old = xb_add(&bar[XB_XSUB(b.x)], 1u);
        const unsigned gen = old / nloc;
        if (old + 1u == (gen + 1u) * nloc) {
            __builtin_amdgcn_fence(__ATOMIC_RELEASE, "agent");
            asm volatile("s_waitcnt vmcnt(0)" ::: "memory");
            const unsigned og = xb_add(&bar[XB_TOP], 1u);
            const unsigned tg = og / nx;
            if (og + 1u == (tg + 1u) * nx) xb_add(&bar[XB_TOPGEN], 1u);
            else XB_SPIN(xb_ld(&bar[XB_TOPGEN]) == tg, bar);
            __builtin_amdgcn_fence(__ATOMIC_ACQUIRE, "agent");
            xb_add(&bar[XB_XGEN(b.x)], 1u);
            asm volatile("s_waitcnt vmcnt(0)" ::: "memory");
        } else {
            XB_SPIN(xb_ld(&bar[XB_XGEN(b.x)]) == gen, bar);
            __builtin_amdgcn_fence(__ATOMIC_ACQUIRE, "agent");
            asm volatile("s_waitcnt vmcnt(0)" ::: "memory");
        }
    }
    __syncthreads();
}


struct Args {
    const float *x_p, *x_s, *cache_k, *cache_v, *state_conv, *c_p, *c_s, *norm1_g, *norm2_g, *w_ada, *b_ada, *w_in, *conv_w, *lq1, *lk1, *lq2, *lk2, *subln_g, *w_o, *w_mlp1, *w_mlp2, *final_g;
    float* out; unsigned char* ws; int never; int pad;
};

__device__ __forceinline__ void p0_transpose_item(const float* W, int K, int N, bf16* WT, LAS float* scr, int item, int lane) {
    const int nblk = N / 32, kb = item / nblk, nb = item % nblk, k0 = 64 * kb, n0 = 32 * nb;
#pragma unroll 8
    for (int i = 0; i < 32; ++i) { const int kk = 2 * i + (lane >> 5); scr[kk * 33 + (lane & 31)] = W[(size_t)(k0 + kk) * N + n0 + (lane & 31)]; }
    LDS_WAIT(); asm volatile("" ::: "memory");
    const int c = lane & 7;
#pragma unroll
    for (int j = 0; j < 4; ++j) { const int n = (lane >> 3) + 8 * j; const LAS float* s = scr + (8 * c) * 33 + n;
        v4u o; o.x = pk2(s[0 * 33], s[1 * 33]); o.y = pk2(s[2 * 33], s[3 * 33]); o.z = pk2(s[4 * 33], s[5 * 33]); o.w = pk2(s[6 * 33], s[7 * 33]);
        *(GAS v4u*)(WT + (size_t)(n0 + n) * K + k0 + 8 * c) = o; }
    LDS_WAIT(); asm volatile("" ::: "memory");
}

__device__ __forceinline__ void norm_mod_row(const float* xrow, const float* g, const float* sc, const float* sh, bf16* orow, int lane) {
    const f32x4* xr = (const f32x4*)xrow + lane;
    f32x4 v[4]; float s = 0.f;
#pragma unroll
    for (int j = 0; j < 4; ++j) { v[j] = xr[64 * j]; s += (v[j].x * v[j].x + v[j].y * v[j].y) + (v[j].z * v[j].z + v[j].w * v[j].w); }
    const float rstd = 1.f / sqrtf(wave_sum(s) * (1.f / DM) + EPS);
    unsigned long long* o8 = (unsigned long long*)orow + lane;
#pragma unroll
    for (int j = 0; j < 4; ++j) { const f32x4 gg = ((const f32x4*)g)[lane + 64 * j], cc = ((const f32x4*)sc)[lane + 64 * j], hh = ((const f32x4*)sh)[lane + 64 * j];
        const f32x4 r = v[j] * rstd * gg * (cc + 1.f) + hh;
        o8[64 * j] = (unsigned long long)pk2(r.x, r.y) | ((unsigned long long)pk2(r.z, r.w) << 32); }
}

__global__ void __launch_bounds__(NTHREADS, 2) mega_fwd(Args a) {
    extern __shared__ __attribute__((aligned(16))) unsigned char lds_raw[];
    LAS unsigned char* lds = (LAS unsigned char*)lds_raw;
    cg::grid_group grid = cg::this_grid();
    const int G = gridDim.x; const int bx = blockIdx.x;
    const int vcu = (G % 8 == 0) ? (bx % 8) * (G / 8) + bx / 8 : bx;
    const int NGW = G * NWAVES;
#define PHASE_IDS() int tid_ = threadIdx.x; asm volatile("" : "+v"(tid_)); const int tid = tid_, lane = tid & 63, wave = __builtin_amdgcn_readfirstlane(tid >> 6), gw = vcu * NWAVES + wave; (void)tid; (void)lane; (void)gw
    unsigned char* ws = a.ws;
    float* mod = (float*)(ws + WS_MOD); float* rowss = (float*)(ws + WS_ROWSS); float* bias2 = (float*)(ws + WS_BIAS2); bf16* SH2 = (bf16*)(ws + WS_SH2);
    bf16 *Win_t = (bf16*)(ws + WS_WIN), *Wo_t = (bf16*)(ws + WS_WO), *W1_t = (bf16*)(ws + WS_W1), *W2_t = (bf16*)(ws + WS_W2);
    bf16 *XN = (bf16*)(ws + WS_XN), *HB = (bf16*)(ws + WS_HB), *BG = (bf16*)(ws + WS_BG), *CG = (bf16*)(ws + WS_CG), *UG = (bf16*)(ws + WS_UG), *QB = (bf16*)(ws + WS_QB);
    bf16 *KB = (bf16*)(ws + WS_KB), *VB = (bf16*)(ws + WS_VB), *MIX = (bf16*)(ws + WS_MIX);
    volatile LAS unsigned* MISC = (volatile LAS unsigned*)(lds + MISC_OFF);
    if (threadIdx.x < 32) MISC[threadIdx.x] = 0u;
    unsigned* barw = (unsigned*)(ws + WS_BAR);
    unsigned* qctr = (unsigned*)(ws + WS_QCTR); unsigned* maxbuf = (unsigned*)(ws + WS_MAXB);
    __syncthreads();
    const XcdBarrier bar = xcd_barrier_post(barw, MISC + 8);
#define GRID_SYNC() xcd_barrier(bar)
    if (a.never) grid.sync();

    { PHASE_IDS();
    if (bx < (6 * DM) / 64) {
        const int cb = bx * 64;
        LAS float* sl = (LAS float*)lds + wave * (64 * NMOD);
        float acc[NMOD];
#pragma unroll
        for (int r = 0; r < NMOD; ++r) acc[r] = 0.f;
        for (int half = 0; half < 2; ++half) {
            const int k0 = wave * 128 + half * 64;
            for (int idx = lane; idx < 64 * NMOD; idx += 64) { const int kk = idx & 63, r = idx >> 6;
                const float cv = r < NB_P ? a.c_p[r * DM + k0 + kk] : a.c_s[(r - NB_P) * DM + k0 + kk];
                sl[kk * NMOD + r] = cv / (1.f + __expf(-cv)); }
            LDS_WAIT(); asm volatile("" ::: "memory");
            for (int kk = 0; kk < 64; ++kk) {
                const float wv = a.w_ada[(size_t)(k0 + kk) * (6 * DM) + cb + lane];
                const LAS f32x4* sp = (const LAS f32x4*)(sl + kk * NMOD);
#pragma unroll
                for (int r4 = 0; r4 < NMOD / 4; ++r4) { const f32x4 sv = sp[r4]; acc[4 * r4] += sv.x * wv; acc[4 * r4 + 1] += sv.y * wv; acc[4 * r4 + 2] += sv.z * wv; acc[4 * r4 + 3] += sv.w * wv; }
            }
            LDS_WAIT(); asm volatile("" ::: "memory");
        }
        __syncthreads();
        LAS float* red = (LAS float*)lds;
#pragma unroll
        for (int r = 0; r < NMOD; ++r) red[(wave * NMOD + r) * 64 + lane] = acc[r];
        __syncthreads();
        for (int idx = tid; idx < NMOD * 64; idx += NTHREADS) { const int r = idx >> 6, cl = idx & 63; float s = a.b_ada[cb + cl];
#pragma unroll
            for (int w8 = 0; w8 < 8; ++w8) s += red[(w8 * NMOD + r) * 64 + cl];
            mod[(size_t)r * (6 * DM) + cb + cl] = s; }
        __syncthreads();
    }
    {
        LAS float* scr = (LAS float*)(lds + wave * 16384);
        constexpr int I_IN = (DM / 64) * (INW / 32), I_O = (DM / 64) * (DM / 32), I_1 = (DM / 64) * (FF / 32), I_2 = (FF / 64) * (DM / 32);
        constexpr int NITEMS = I_IN + I_O + I_1 + I_2;
        for (int it = gw; it < NITEMS; it += NGW) {
            int r = it;
            if (r < I_IN) { p0_transpose_item(a.w_in, DM, INW, Win_t, scr, r, lane); continue; } r -= I_IN;
            if (r < I_O) { p0_transpose_item(a.w_o, DM, DM, Wo_t, scr, r, lane); continue; } r -= I_O;
            if (r < I_1) { p0_transpose_item(a.w_mlp1, DM, FF, W1_t, scr, r, lane); continue; } r -= I_1;
            p0_transpose_item(a.w_mlp2, FF, DM, W2_t, scr, r, lane);
        }
        constexpr int NC = NB_S * PAST;
        for (int it = gw; it < 2 * NC; it += NGW) {
            const int which = it >= NC, r = which ? it - NC : it, b = r >> 10, t = r & 1023;
            const float* src = (which ? a.cache_v : a.cache_k) + (size_t)r * HW + lane * 8;
            const f32x4 v0 = *(const f32x4*)src, v1 = *(const f32x4*)(src + 4);
            v4u o; o.x = pk2(v0.x, v0.y); o.y = pk2(v0.z, v0.w); o.z = pk2(v1.x, v1.y); o.w = pk2(v1.z, v1.w);
            *(v4u*)((which ? VB : KB) + (size_t)(MP + b * KVS + t) * HW + lane * 8) = o;
        }
        for (int it = gw; it < 2 * NB_S * 32; it += NGW) {
            const int which = it >= NB_S * 32, r = which ? it - NB_S * 32 : it, b = r >> 5, t = PAST + T_S + (r & 31);
            *(v4u*)((which ? VB : KB) + (size_t)(MP + b * KVS + t) * HW + lane * 8) = (v4u){0u, 0u, 0u, 0u};
        }
    }
    }
    GRID_SYNC();

    { PHASE_IDS();
    if (gw < 256) { unsigned long long* o8 = (unsigned long long*)(SH2 + (size_t)gw * DM) + lane; const f32x4* sp = (const f32x4*)(mod + (size_t)(gw < NMOD ? gw : 0) * (6 * DM) + 3 * DM) + lane;
#pragma unroll
        for (int j = 0; j < 4; ++j) { f32x4 r = sp[64 * j]; if (gw >= NMOD) r = (f32x4){0.f, 0.f, 0.f, 0.f}; o8[64 * j] = (unsigned long long)pk2(r.x, r.y) | ((unsigned long long)pk2(r.z, r.w) << 32); } }
    for (int m = gw; m < MT; m += 2 * NGW) {
        const int m2r = m + NGW; const bool h2 = m2r < MT; const int m2 = h2 ? m2r : m;
        const int mrow = m < MP ? (m >> 13) : NB_P + ((m - MP) >> 5), mrow2 = m2 < MP ? (m2 >> 13) : NB_P + ((m2 - MP) >> 5);
        const f32x4* xa = (const f32x4*)(m < MP ? a.x_p + (size_t)m * DM : a.x_s + (size_t)(m - MP) * DM) + lane;
        const f32x4* xb = (const f32x4*)(m2 < MP ? a.x_p + (size_t)m2 * DM : a.x_s + (size_t)(m2 - MP) * DM) + lane;
        const f32x4* ma = (const f32x4*)(mod + (size_t)mrow * (6 * DM)) + lane; const f32x4* mb = (const f32x4*)(mod + (size_t)mrow2 * (6 * DM)) + lane;
        f32x4 va[4], vb[4]; float sa = 0.f, sb = 0.f;
#pragma unroll
        for (int j = 0; j < 4; ++j) { va[j] = xa[64 * j]; vb[j] = xb[64 * j]; }
#pragma unroll
        for (int j = 0; j < 4; ++j) { sa += (va[j].x * va[j].x + va[j].y * va[j].y) + (va[j].z * va[j].z + va[j].w * va[j].w); sb += (vb[j].x * vb[j].x + vb[j].y * vb[j].y) + (vb[j].z * vb[j].z + vb[j].w * vb[j].w); }
        sa = wave_sum(sa); sb = wave_sum(sb);
        const float ra = 1.f / sqrtf(sa * (1.f / DM) + EPS), rb = 1.f / sqrtf(sb * (1.f / DM) + EPS);
        unsigned long long* oa = (unsigned long long*)(XN + (size_t)m * DM) + lane; unsigned long long* ob = (unsigned long long*)(XN + (size_t)m2 * DM) + lane;
#pragma unroll
        for (int j = 0; j < 4; ++j) { const f32x4 gg = ((const f32x4*)a.norm1_g)[lane + 64 * j];
            const f32x4 r1 = va[j] * ra * gg * (ma[DM / 4 + 64 * j] + 1.f) + ma[64 * j];
            oa[64 * j] = (unsigned long long)pk2(r1.x, r1.y) | ((unsigned long long)pk2(r1.z, r1.w) << 32);
            if (h2) { const f32x4 r2 = vb[j] * rb * gg * (mb[DM / 4 + 64 * j] + 1.f) + mb[64 * j];
                ob[64 * j] = (unsigned long long)pk2(r2.x, r2.y) | ((unsigned long long)pk2(r2.z, r2.w) << 32); } }
    } }
    GRID_SYNC();

    {
        pg8::Gemm g{XN, Win_t, MT, INW, DM}; pg8::StaticOrder S; S.init(MT, INW, G, bx, 1);
        pg8::EpiIn E{BG, CG, UG, QB, KB, VB, a.out, maxbuf};
        pg8::gemm_phase<pg8::EpiIn, pg8::StaticOrder, true, true>(lds, g, S, E);
    }
    GRID_SYNC();

    { PHASE_IDS();
        float lam;
        { float d1 = 0.f, d2 = 0.f; for (int i = 0; i < 64; ++i) { d1 += a.lq1[i] * a.lk1[i]; d2 += a.lq2[i] * a.lk2[i]; } lam = __expf(d1) - __expf(d2) + 0.2f; }
        constexpr int NQI = 256 + (NB_S * 4) / 8;
        int qi = (int)(bar.x & 7u);
        for (int nq = 0; nq < 8;) {
            if (tid == 0) MISC[0] = __hip_atomic_fetch_add(qctr + 64 * qi, 1u, __ATOMIC_RELAXED, __HIP_MEMORY_SCOPE_AGENT);
            __syncthreads();
            const int idx = (int)MISC[0];
            __syncthreads();
            if (idx >= NQI) { qi = (qi + 1) & 7; ++nq; continue; }
            att::UnitDesc d;
            if (idx < 256) {
                const int b = qi, h = 3 - (idx >> 6), qb = 63 - (idx & 63);
                const size_t row0 = (size_t)b * T_P + 128 * qb;
                d.Q = QB + row0 * HW + h * 128; d.K = KB + (size_t)b * T_P * HW + h * 128; d.V = VB + (size_t)b * T_P * HW + h * 128; d.O = MIX + row0 * DM + 512 + h * 128;
                d.q0pos = 128 * qb; d.nvalid = 128; d.kv_len = T_P; d.s_hi = qb; d.slope2 = LOG2E * exp2f(-2.f * (float)(h + 1));
                const unsigned* mq = maxbuf + b * 16 + h * 4; const unsigned* mk = mq + 128;
                const float B0 = sqrtf(__uint_as_float(mq[0]) * __uint_as_float(mk[0])) + sqrtf(__uint_as_float(mq[1]) * __uint_as_float(mk[1]));
                const float B1 = sqrtf(__uint_as_float(mq[2]) * __uint_as_float(mk[2])) + sqrtf(__uint_as_float(mq[3]) * __uint_as_float(mk[3]));
                const float Tn = 2.04f * fmaxf(B0, B1) + 160.f, X = ((float)d.q0pos - 127.f - Tn / d.slope2) * (1.f / 128.f);
                int slo = X > 0.f ? (int)floorf(X) : 0; d.s_lo = slo < qb ? slo : qb;
            } else {
                const int us = qi * ((NB_S * 4) / 8) + idx - 256, b = us >> 2, h = us & 3;
                const size_t row0 = (size_t)MP + b * T_S, kr0 = (size_t)MP + (size_t)b * KVS;
                d.Q = QB + row0 * HW + h * 128; d.K = KB + kr0 * HW + h * 128; d.V = VB + kr0 * HW + h * 128; d.O = MIX + row0 * DM + 512 + h * 128;
                d.q0pos = PAST; d.nvalid = T_S; d.kv_len = PAST + T_S; d.s_hi = (KVS / 64) / 2; d.s_lo = 0; d.slope2 = LOG2E * exp2f(-2.f * (float)(h + 1));
            }
            att::attn_unit(lds, d, lam, a.subln_g);
        }
        const int ch0 = lane * 8;
        float w0[8], w1[8], w2[8];
#pragma unroll
        for (int e = 0; e < 8; ++e) { w0[e] = a.conv_w[ch0 + e]; w1[e] = a.conv_w[HW + ch0 + e]; w2[e] = a.conv_w[2 * HW + ch0 + e]; }
        for (int r = gw; r < MT; r += NGW) {
            const bool smp = r >= MP; const int t = smp ? ((r - MP) & 31) : (r & (T_P - 1)), T = smp ? T_S : T_P, b = smp ? ((r - MP) >> 5) : (r >> 13);
            float uc[3][8];
#pragma unroll
            for (int k = 0; k < 3; ++k) {
                if (t - k >= 0) { const v4u cv = *(const v4u*)(CG + (size_t)(r - k) * HW + ch0), uv = *(const v4u*)(UG + (size_t)(r - k) * HW + ch0);
                    uc[k][0] = bflo(cv.x) * bflo(uv.x); uc[k][1] = bfhi(cv.x) * bfhi(uv.x); uc[k][2] = bflo(cv.y) * bflo(uv.y); uc[k][3] = bfhi(cv.y) * bfhi(uv.y);
                    uc[k][4] = bflo(cv.z) * bflo(uv.z); uc[k][5] = bfhi(cv.z) * bfhi(uv.z); uc[k][6] = bflo(cv.w) * bflo(uv.w); uc[k][7] = bfhi(cv.w) * bfhi(uv.w);
                } else if (smp) { const float* sp = a.state_conv + ((size_t)b * 2 + (2 + t - k)) * HW + ch0; const f32x4 s0 = *(const f32x4*)sp, s1 = *(const f32x4*)(sp + 4);
                    uc[k][0] = s0.x; uc[k][1] = s0.y; uc[k][2] = s0.z; uc[k][3] = s0.w; uc[k][4] = s1.x; uc[k][5] = s1.y; uc[k][6] = s1.z; uc[k][7] = s1.w;
                } else {
#pragma unroll
                    for (int e = 0; e < 8; ++e) uc[k][e] = 0.f; }
            }
            const v4u bv = *(const v4u*)(BG + (size_t)r * HW + ch0);
            float bb[8] = {bflo(bv.x), bfhi(bv.x), bflo(bv.y), bfhi(bv.y), bflo(bv.z), bfhi(bv.z), bflo(bv.w), bfhi(bv.w)};
            float y[8];
#pragma unroll
            for (int e = 0; e < 8; ++e) y[e] = bb[e] * (w0[e] * uc[2][e] + w1[e] * uc[1][e] + w2[e] * uc[0][e]);
            v4u o; o.x = pk2(y[0], y[1]); o.y = pk2(y[2], y[3]); o.z = pk2(y[4], y[5]); o.w = pk2(y[6], y[7]);
            *(v4u*)(MIX + (size_t)r * DM + ch0) = o;
            if (t >= T - 2) { float* cp = a.out + (smp ? O_CS : O_CP) + ((size_t)b * 2 + (t - (T - 2))) * HW + ch0;
                *(f32x4*)cp = (f32x4){uc[0][0], uc[0][1], uc[0][2], uc[0][3]}; *(f32x4*)(cp + 4) = (f32x4){uc[0][4], uc[0][5], uc[0][6], uc[0][7]}; }
        }
    }
    GRID_SYNC();

    {
        pg8::Gemm g{MIX, Wo_t, MT, DM, DM}; pg8::StaticOrder S; S.init(MT, DM, G, bx);
        pg8::EpiResGate2 E{a.x_p, a.x_s, a.out, mod + 2 * DM, mod + 4 * DM, a.norm2_g, XN, rowss};
        pg8::gemm_phase<pg8::EpiResGate2, pg8::StaticOrder, true, true>(lds, g, S, E);
        const int c2 = G >= 48 ? bx - 16 : bx;
        if (c2 >= 0 && c2 < 16) { pg8::Gemm gb{SH2, W1_t, 256, FF, DM, 0}; pg8::SplitOrder Sb{1, FF / 256, 1, 1, 16, c2};
            pg8::EpiPartial Eb{bias2, 1, 256, FF};
            pg8::gemm_phase<pg8::EpiPartial, pg8::SplitOrder, true, true>(lds, gb, Sb, Eb); }
    }
    GRID_SYNC();

    {
        pg8::Gemm g{XN, W1_t, MT, FF, DM}; pg8::StaticOrder S; S.init(MT, FF, G, bx);
        pg8::EpiRelu2N E{HB, FF, rowss, bias2};
        pg8::gemm_phase<pg8::EpiRelu2N, pg8::StaticOrder, true, true>(lds, g, S, E);
    }
    GRID_SYNC();

    {
        pg8::Gemm g{HB, W2_t, MP, DM, FF}; pg8::StaticOrder S; S.init(MP, DM, G, bx);
        pg8::EpiResGate E{a.out, a.out + (size_t)MP * DM, a.out, mod + 5 * DM};
        pg8::gemm_phase<pg8::EpiResGate, pg8::StaticOrder, true, true>(lds, g, S, E);
        pg8::Gemm g2{HB + (size_t)MP * FF, W2_t, MS, DM, FF, 256}; pg8::SplitOrder S2{MS / 256, DM / 256, FF / 256, 256, G, bx};
        pg8::EpiPartial E2{(float*)(ws + WS_XN), 256, MS, DM};
        pg8::gemm_phase<pg8::EpiPartial, pg8::SplitOrder, true, true>(lds, g2, S2, E2);
    }
    GRID_SYNC();

    { PHASE_IDS();
    for (int m = gw; m < MP; m += 2 * NGW) {
        const int m2 = m + NGW; const bool h2 = m2 < MP;
        f32x4* xa = (f32x4*)(a.out + (size_t)m * DM) + lane; f32x4* xb = (f32x4*)(a.out + (size_t)(h2 ? m2 : m) * DM) + lane;
        f32x4 va[4], vb[4]; float sa = 0.f, sb = 0.f;
#pragma unroll
        for (int j = 0; j < 4; ++j) { va[j] = xa[64 * j]; vb[j] = xb[64 * j]; }
#pragma unroll
        for (int j = 0; j < 4; ++j) { sa += (va[j].x * va[j].x + va[j].y * va[j].y) + (va[j].z * va[j].z + va[j].w * va[j].w); sb += (vb[j].x * vb[j].x + vb[j].y * vb[j].y) + (vb[j].z * vb[j].z + vb[j].w * vb[j].w); }
        sa = wave_sum(sa); sb = wave_sum(sb);
        const float ra = 1.f / sqrtf(sa * (1.f / DM) + EPS), rb = 1.f / sqrtf(sb * (1.f / DM) + EPS);
#pragma unroll
        for (int j = 0; j < 4; ++j) { const f32x4 g = ((const f32x4*)a.final_g)[lane + 64 * j]; xa[64 * j] = va[j] * ra * g; if (h2) xb[64 * j] = vb[j] * rb * g; }
    }
    for (int m = MP + gw; m < MT; m += NGW) {
        f32x4* xr = (f32x4*)(a.out + (size_t)m * DM) + lane;
        f32x4 v[4]; float s = 0.f;
#pragma unroll
        for (int j = 0; j < 4; ++j) v[j] = xr[64 * j];
        const f32x4* pp = (const f32x4*)(ws + WS_XN) + (size_t)(m - MP) * (DM / 4) + lane; const f32x4* gp = (const f32x4*)(mod + (size_t)(NB_P + ((m - MP) >> 5)) * (6 * DM) + 5 * DM) + lane;
        f32x4 t[4];
#pragma unroll
        for (int j = 0; j < 4; ++j) t[j] = pp[64 * j];
        for (int s2 = 1; s2 < FF / 256; ++s2) { pp += (size_t)MS * (DM / 4);
#pragma unroll
            for (int j = 0; j < 4; ++j) t[j] += pp[64 * j]; }
#pragma unroll
        for (int j = 0; j < 4; ++j) { v[j] += gp[64 * j] * t[j]; s += (v[j].x * v[j].x + v[j].y * v[j].y) + (v[j].z * v[j].z + v[j].w * v[j].w); }
        const float rstd = 1.f / sqrtf(wave_sum(s) * (1.f / DM) + EPS);
#pragma unroll
        for (int j = 0; j < 4; ++j) xr[64 * j] = v[j] * rstd * ((const f32x4*)a.final_g)[lane + 64 * j];
    } }
}

extern "C" void kernel_launch(void* const* d_in, const int* in_sizes, int n_in, void* d_out, int out_size, void* d_ws, size_t ws_size, hipStream_t stream) {
    static int grid = 0;
    if (grid == 0) {
        if (n_in != 22 || in_sizes[0] != MP * DM || (size_t)out_size != O_END || ws_size < WS_END) {
            fprintf(stderr, "kernel_launch: unexpected shapes: n_in %d in0 %d out %d ws %zu (need %zu)\n", n_in, n_in > 0 ? in_sizes[0] : -1, out_size, ws_size, (size_t)WS_END); grid = -1; return; }
        int dev = 0, cus = 0, per_cu = 0;
        (void)hipGetDevice(&dev); (void)hipDeviceGetAttribute(&cus, hipDeviceAttributeMultiprocessorCount, dev);
        if (hipFuncSetAttribute((const void*)mega_fwd, hipFuncAttributeMaxDynamicSharedMemorySize, LDS_BYTES) != hipSuccess) { fprintf(stderr, "kernel_launch: hipFuncSetAttribute failed\n"); grid = -1; return; }
        if (hipOccupancyMaxActiveBlocksPerMultiprocessor(&per_cu, (const void*)mega_fwd, NTHREADS, LDS_BYTES) != hipSuccess || per_cu < 1) { fprintf(stderr, "kernel_launch: occupancy query says %d\n", per_cu); per_cu = 1; }
        (void)hipGetLastError();
        grid = cus * per_cu;
        fprintf(stderr, "kernel_launch: grid %d (cus %d x %d)\n", grid, cus, per_cu);
    }
    if (grid < 0) return;
    Args a{};
    const float** p = (const float**)&a;
    for (int i = 0; i < 22; ++i) p[i] = (const float*)d_in[i];
    a.out = (float*)d_out; a.ws = (unsigned char*)d_ws;
    if (hipMemsetAsync((char*)d_ws + WS_BAR, 0, CTL_BYTES, stream) != hipSuccess) { fprintf(stderr, "kernel_launch: hipMemsetAsync failed\n"); return; }
    void* args[] = {&a};
    hipError_t e = hipLaunchCooperativeKernel((const void*)mega_fwd, dim3(grid), dim3(NTHREADS), args, LDS_BYTES, stream);
    if (e != hipSuccess) fprintf(stderr, "kernel_launch: cooperative launch failed: %s (grid %d)\n", hipGetErrorString(e), grid);
}
```

```cpp
#include <hip/hip_runtime.h>
#include <hip/hip_cooperative_groups.h>
#include <cstdio>
#include <cstdint>
namespace cg = cooperative_groups;

constexpr int DM = 1024, NB_P = 8, T_P = 8192, NB_S = 32, T_S = 32, PAST = 1024;
constexpr int MP = NB_P * T_P, MS = NB_S * T_S, MT = MP + MS;
constexpr int INW = 3072, FF = 4096, HW = 512;
constexpr int KVS = 1088;
constexpr int KVROWS = MP + NB_S * KVS;
constexpr int NMOD = NB_P + NB_S;
constexpr float EPS = 1e-5f;
constexpr float LOG2E = 1.4426950408889634f;
constexpr float QSCALE = 0.125f * LOG2E;
constexpr size_t O_YP = 0, O_YS = (size_t)MP * DM, O_KP = O_YS + (size_t)MS * DM, O_VP = O_KP + (size_t)MP * HW, O_CP = O_VP + (size_t)MP * HW,
                 O_KS = O_CP + (size_t)NB_P * 2 * HW, O_VS = O_KS + (size_t)MS * HW, O_CS = O_VS + (size_t)MS * HW, O_END = O_CS + (size_t)NB_S * 2 * HW;

namespace pg8 {
#define PG8_LAS __attribute__((address_space(3)))
typedef unsigned short bf16_t;
typedef short bf16x8 __attribute__((ext_vector_type(8)));
typedef float f32x4 __attribute__((ext_vector_type(4)));
typedef unsigned u32x4 __attribute__((ext_vector_type(4)));
constexpr int BM = 256, BK = 64, HALF = 128, HTB = HALF * BK * 2  , STAGE_BYTES = 8 * HTB, NXCD = 8, WGM = 8;

__host__ __device__ __forceinline__ int lds_byte(int r, int c) { const int st = (r >> 4) * 2 + (c >> 5), rr = r & 15, cc = c & 31, ob = rr * 64 + cc * 2; return st * 1024 + (ob ^ (((ob >> 9) & 1) << 5)); }
__host__ __device__ __forceinline__ void stage_rc(int b, int& R, int& C) { const int st = b / 1024, sb = b % 1024, swz = sb ^ (((sb >> 9) & 1) << 5); R = (st >> 1) * 16 + swz / 64; C = (st & 1) * 32 + (swz % 64) / 2; }
__host__ __device__ __forceinline__ int perm32(int rho) { const int n = rho >> 4, i = rho & 15; return 8 * (i >> 2) + 4 * n + (i & 3); }

struct Unit { int pm, pn, k0; };
struct Gemm { const bf16_t* A; const bf16_t* Bt; int M, N, K, Kext; };

struct StaticOrder {
    int nM, nN, nwg, G, c, rot;
    __host__ __device__ void init(int M, int N, int G_, int c_, int rot_ = 0) { nM = M / BM; nN = N / BM; nwg = nM * nN; G = G_; c = c_; rot = rot_; }
    __host__ __device__ bool next(int i, Unit& u) const {
        const long L = (long)i * G + c; if (L >= nwg) return false;
        int wgid = (int)L; { const int q = nwg / NXCD, r = nwg % NXCD, xcd = wgid % NXCD, off = wgid / NXCD; wgid = (xcd < r ? xcd * (q + 1) : r * (q + 1) + (xcd - r) * q) + off; }
        const int nig = WGM * nN, gid = wgid / nig, fm = gid * WGM, gsz = (nM - fm) < WGM ? (nM - fm) : WGM;
        u.pm = fm + ((wgid % nig) % gsz); u.pn = ((wgid % nig) / gsz + (rot ? ((gid >> 2) * 3) % nN : 0)) % nN; u.k0 = 0; return true;
    }
    __device__ __forceinline__ void a_ready(const Unit&) const {}
    __device__ __forceinline__ void done(const Unit&) const {}
};

struct SplitOrder {
    int nM, nN, nS, ksz, G, c;
    __host__ __device__ bool next(int i, Unit& u) const { const int L = i * G + c; if (L >= nM * nN * nS) return false; u.pm = L % nM; u.pn = (L / nM) % nN; u.k0 = (L / (nM * nN)) * ksz; return true; }
    __device__ __forceinline__ void a_ready(const Unit&) const {}
    __device__ __forceinline__ void done(const Unit&) const {}
};

__device__ __forceinline__ unsigned cvt_pk_bf16(float lo, float hi) { unsigned r; asm volatile("v_cvt_pk_bf16_f32 %0, %1, %2" : "=v"(r) : "v"(lo), "v"(hi)); return r; }
__device__ __forceinline__ u32x4 pack8(f32x4 v0, f32x4 v1) { u32x4 w; w.x = cvt_pk_bf16(v0[0], v0[1]); w.y = cvt_pk_bf16(v0[2], v0[3]); w.z = cvt_pk_bf16(v1[0], v1[1]); w.w = cvt_pk_bf16(v1[2], v1[3]); return w; }

__device__ __forceinline__ float fq_sum(float v) {
    auto a = __builtin_amdgcn_permlane16_swap(__float_as_uint(v), __float_as_uint(v), false, false); v = __uint_as_float(a[0]) + __uint_as_float(a[1]);
    auto b = __builtin_amdgcn_permlane32_swap(__float_as_uint(v), __float_as_uint(v), false, false); return __uint_as_float(b[0]) + __uint_as_float(b[1]); }
struct EpiIn {
    static constexpr bool PERM = true, AFTER_DRAIN = false;
    bf16_t *BG, *CG, *UG, *QB, *KB, *VB; float* out; unsigned* maxbuf;
    __device__ __forceinline__ void operator()(const f32x4 (&acc)[2][2][4][2], const Unit& u, int wr, int wc, int fr, int fq) const {
        const int seg = u.pn >> 1, col0 = (u.pn & 1) * 256 + wc * 32 + 8 * fq, row0 = u.pm * BM + wr * 64 + fr;
        const bool smp = u.pm >= (MP / BM);
        if (!smp && (seg == 3 || seg == 4)) {
            const float sc2 = seg == 3 ? QSCALE * QSCALE : 1.f; float mx[2] = {0.f, 0.f};
#pragma unroll
            for (int ai = 0; ai < 2; ++ai)
#pragma unroll
                for (int m = 0; m < 4; ++m)
#pragma unroll
                    for (int bj = 0; bj < 2; ++bj) { const f32x4 v0 = acc[ai][bj][m][0], v1 = acc[ai][bj][m][1];
                        float ss = (v0[0] * v0[0] + v0[1] * v0[1]) + (v0[2] * v0[2] + v0[3] * v0[3]) + (v1[0] * v1[0] + v1[1] * v1[1]) + (v1[2] * v1[2] + v1[3] * v1[3]);
                        ss = fq_sum(ss); mx[bj] = fmaxf(mx[bj], ss * sc2); }
#pragma unroll
            for (int bj = 0; bj < 2; ++bj)
                if (fq == 0) atomicMax(maxbuf + (seg == 4 ? 128 : 0) + (u.pm >> 5) * 16 + (u.pn & 1) * 8 + bj * 4 + wc, __float_as_uint(mx[bj]));
        }
        if (seg < 4) {
            bf16_t* base = seg == 0 ? BG : seg == 1 ? CG : seg == 2 ? UG : QB; const float sc = seg == 3 ? QSCALE : 1.f;
#pragma unroll
            for (int ai = 0; ai < 2; ++ai)
#pragma unroll
                for (int m = 0; m < 4; ++m) { bf16_t* rowp = base + (size_t)(row0 + ai * HALF + m * 16) * HW + col0;
#pragma unroll
                    for (int bj = 0; bj < 2; ++bj) *(u32x4*)(rowp + bj * HALF) = pack8(acc[ai][bj][m][0] * sc, acc[ai][bj][m][1] * sc); }
        } else {
            bf16_t* kvb = seg == 4 ? KB : VB;
            float* ob = out + (smp ? (seg == 4 ? O_KS : O_VS) : (seg == 4 ? O_KP : O_VP));
#pragma unroll
            for (int ai = 0; ai < 2; ++ai)
#pragma unroll
                for (int m = 0; m < 4; ++m) { const int row = row0 + ai * HALF + m * 16; const int rs = row - MP;
                    const size_t orow = smp ? (size_t)rs : (size_t)row;
                    const size_t kvrow = smp ? (size_t)(MP + (rs >> 5) * KVS + PAST + (rs & 31)) : (size_t)row;
                    float* op = ob + orow * HW + col0; bf16_t* kp = kvb + kvrow * HW + col0;
#pragma unroll
                    for (int bj = 0; bj < 2; ++bj) { const f32x4 v0 = acc[ai][bj][m][0], v1 = acc[ai][bj][m][1];
                        __builtin_nontemporal_store(v0, (f32x4*)(op + bj * HALF)); __builtin_nontemporal_store(v1, (f32x4*)(op + bj * HALF + 4)); *(u32x4*)(kp + bj * HALF) = pack8(v0, v1); } }
        }
    }
};
struct EpiResGate {
    static constexpr bool PERM = true, AFTER_DRAIN = false;
    const float* res_p; const float* res_s; float* out; const float* gate;
    __device__ __forceinline__ void operator()(const f32x4 (&acc)[2][2][4][2], const Unit& u, int wr, int wc, int fr, int fq) const {
        const int col0 = u.pn * BM + wc * 32 + 8 * fq, row0 = u.pm * BM + wr * 64 + fr;
#pragma unroll
        for (int ai = 0; ai < 2; ++ai)
#pragma unroll
            for (int m = 0; m < 4; ++m) { const int row = row0 + ai * HALF + m * 16;
                const int mrow = row < MP ? (row >> 13) : NB_P + ((row - MP) >> 5);
                const float* rp = (row < MP ? res_p + (size_t)row * DM : res_s + (size_t)(row - MP) * DM) + col0;
                const float* gp = gate + (size_t)mrow * (6 * DM) + col0; float* op = out + (size_t)row * DM + col0;
#pragma unroll
                for (int bj = 0; bj < 2; ++bj) {
                    const f32x4 g0 = *(const f32x4*)(gp + bj * HALF), g1 = *(const f32x4*)(gp + bj * HALF + 4);
                    const f32x4 x0 = *(const f32x4*)(rp + bj * HALF), x1 = *(const f32x4*)(rp + bj * HALF + 4);
                    *(f32x4*)(op + bj * HALF) = x0 + g0 * acc[ai][bj][m][0]; *(f32x4*)(op + bj * HALF + 4) = x1 + g1 * acc[ai][bj][m][1]; }
                if (m & 1) asm volatile("" ::: "memory"); }
    }
};
struct EpiRelu2 {
    static constexpr bool PERM = true, AFTER_DRAIN = false;
    bf16_t* O; int ldc;
    __device__ __forceinline__ void operator()(const f32x4 (&acc)[2][2][4][2], const Unit& u, int wr, int wc, int fr, int fq) const {
        const int col0 = u.pn * BM + wc * 32 + 8 * fq, row0 = u.pm * BM + wr * 64 + fr;
#pragma unroll
        for (int ai = 0; ai < 2; ++ai)
#pragma unroll
            for (int m = 0; m < 4; ++m) { bf16_t* rowp = O + (size_t)(row0 + ai * HALF + m * 16) * ldc + col0;
#pragma unroll
                for (int bj = 0; bj < 2; ++bj) { f32x4 v0 = acc[ai][bj][m][0], v1 = acc[ai][bj][m][1];
#pragma unroll
                    for (int e = 0; e < 4; ++e) { const float a = fmaxf(v0[e], 0.f), b = fmaxf(v1[e], 0.f); v0[e] = a * a; v1[e] = b * b; }
                    *(u32x4*)(rowp + bj * HALF) = pack8(v0, v1); } }
    }
};

struct EpiResGate2 {
    static constexpr bool PERM = true, AFTER_DRAIN = false;
    const float* res_p; const float* res_s; float* out; const float* gate; const float* sc2; const float* n2g; bf16_t* XN; float* rowss;
    __device__ __forceinline__ void operator()(const f32x4 (&acc)[2][2][4][2], const Unit& u, int wr, int wc, int fr, int fq) const {
        const int col0 = u.pn * BM + wc * 32 + 8 * fq, row0 = u.pm * BM + wr * 64 + fr;
#pragma unroll
        for (int ai = 0; ai < 2; ++ai)
#pragma unroll
            for (int m = 0; m < 4; ++m) { const int row = row0 + ai * HALF + m * 16;
                const int mrow = row < MP ? (row >> 13) : NB_P + ((row - MP) >> 5);
                const float* rp = (row < MP ? res_p + (size_t)row * DM : res_s + (size_t)(row - MP) * DM) + col0;
                const float* gp = gate + (size_t)mrow * (6 * DM) + col0; const float* cp = sc2 + (size_t)mrow * (6 * DM) + col0; float* op = out + (size_t)row * DM + col0;
                bf16_t* xp = XN + (size_t)row * DM + col0; float ss = 0.f;
#pragma unroll
                for (int bj = 0; bj < 2; ++bj) {
                    const f32x4 g0 = *(const f32x4*)(gp + bj * HALF), g1 = *(const f32x4*)(gp + bj * HALF + 4);
                    const f32x4 x0 = *(const f32x4*)(rp + bj * HALF), x1 = *(const f32x4*)(rp + bj * HALF + 4);
                    const f32x4 y0 = x0 + g0 * acc[ai][bj][m][0], y1 = x1 + g1 * acc[ai][bj][m][1];
                    *(f32x4*)(op + bj * HALF) = y0; *(f32x4*)(op + bj * HALF + 4) = y1;
                    ss += (y0[0] * y0[0] + y0[1] * y0[1]) + (y0[2] * y0[2] + y0[3] * y0[3]) + (y1[0] * y1[0] + y1[1] * y1[1]) + (y1[2] * y1[2] + y1[3] * y1[3]);
                    const f32x4 n0 = *(const f32x4*)(n2g + col0 + bj * HALF), n1 = *(const f32x4*)(n2g + col0 + bj * HALF + 4);
                    const f32x4 c0 = *(const f32x4*)(cp + bj * HALF), c1 = *(const f32x4*)(cp + bj * HALF + 4);
                    *(u32x4*)(xp + bj * HALF) = pack8(y0 * n0 * (c0 + 1.f), y1 * n1 * (c1 + 1.f)); }
                ss = fq_sum(ss);
                if (fq == 0) unsafeAtomicAdd(rowss + row, ss);
                asm volatile("" ::: "memory"); }
    }
};
struct EpiRelu2N {
    static constexpr bool PERM = true, AFTER_DRAIN = false;
    bf16_t* O; int ldc; const float* rowss; const float* bias2;
    __device__ __forceinline__ void operator()(const f32x4 (&acc)[2][2][4][2], const Unit& u, int wr, int wc, int fr, int fq) const {
        const int col0 = u.pn * BM + wc * 32 + 8 * fq, row0 = u.pm * BM + wr * 64 + fr;
#pragma unroll
        for (int ai = 0; ai < 2; ++ai)
#pragma unroll
            for (int m = 0; m < 4; ++m) { const int row = row0 + ai * HALF + m * 16; const int mrow = row < MP ? (row >> 13) : NB_P + ((row - MP) >> 5);
                const float rstd = 1.f / sqrtf(rowss[row] * (1.f / DM) + EPS);
                const float* bp = bias2 + (size_t)mrow * FF + col0; bf16_t* rowp = O + (size_t)row * ldc + col0;
#pragma unroll
                for (int bj = 0; bj < 2; ++bj) { f32x4 v0 = acc[ai][bj][m][0] * rstd + *(const f32x4*)(bp + bj * HALF), v1 = acc[ai][bj][m][1] * rstd + *(const f32x4*)(bp + bj * HALF + 4);
#pragma unroll
                    for (int e = 0; e < 4; ++e) { const float a = fmaxf(v0[e], 0.f), b = fmaxf(v1[e], 0.f); v0[e] = a * a; v1[e] = b * b; }
                    *(u32x4*)(rowp + bj * HALF) = pack8(v0, v1); } }
    }
};
struct EpiPartial {
    static constexpr bool PERM = true, AFTER_DRAIN = false;
    float* part; int ksz, nrows, ld;
    __device__ __forceinline__ void operator()(const f32x4 (&acc)[2][2][4][2], const Unit& u, int wr, int wc, int fr, int fq) const {
        const int col0 = u.pn * BM + wc * 32 + 8 * fq, row0 = u.pm * BM + wr * 64 + fr;
        float* pb = part + (size_t)(u.k0 / ksz) * nrows * ld;
#pragma unroll
        for (int ai = 0; ai < 2; ++ai)
#pragma unroll
            for (int m = 0; m < 4; ++m) { float* op = pb + (size_t)(row0 + ai * HALF + m * 16) * ld + col0;
#pragma unroll
                for (int bj = 0; bj < 2; ++bj) { *(f32x4*)(op + bj * HALF) = acc[ai][bj][m][0]; *(f32x4*)(op + bj * HALF + 4) = acc[ai][bj][m][1]; } }
    }
};

template <class Epi, class Sched, bool ALIGN_EPI = false, bool SP2 = false>
__device__ __forceinline__ void gemm_phase(PG8_LAS unsigned char* lds, const Gemm g, const Sched& S, const Epi& E) {
    int tid = threadIdx.x; asm volatile("" : "+v"(tid));
    const int wid = __builtin_amdgcn_readfirstlane(tid >> 6), lane = tid & 63, wr = wid >> 2, wc = wid & 3, fr = lane & 15, fq = lane >> 4;
    const int K = g.K, nt = (g.Kext ? g.Kext : K) / BK;
    unsigned voffA[2], voffB[2];
#pragma unroll
    for (int i = 0; i < 2; ++i) { int R, C; stage_rc(tid * 16 + i * 8192, R, C); const int Rb = Epi::PERM ? ((R & ~31) + perm32(R & 31)) : R;
        voffA[i] = (unsigned)(R * K + C) * 2u; voffB[i] = (unsigned)(Rb * K + C) * 2u; }
    const size_t kstep = (size_t)(BK * 2);
    const size_t hstep = (size_t)HALF * K * 2;
    const size_t tstep = 2 * hstep;
    const unsigned ldsw = (unsigned)wid * 1024u;
    const int aoff = lds_byte(wr * 64 + fr, fq * 8), boff = lds_byte(wc * 32 + fr, fq * 8);
#define PG8_SA(b, h) (((b) * 2 + (h)) * HTB)
#define PG8_SB(b, h) ((4 + (b) * 2 + (h)) * HTB)
#define PG8_STAGE(bufoff, gbase, voff) do { _Pragma("unroll") for (int _i = 0; _i < 2; ++_i) \
        __builtin_amdgcn_global_load_lds((const unsigned*)((const char*)(gbase) + (voff)[_i]), (PG8_LAS unsigned*)(lds + (bufoff) + ldsw + _i * 8192), 16, 0, 0); } while (0)
#define PG8_LDA(dst, b, h) do { _Pragma("unroll") for (int m = 0; m < 4; ++m) _Pragma("unroll") for (int k = 0; k < 2; ++k) dst[m][k] = *(const PG8_LAS bf16x8*)(lds + PG8_SA(b, h) + aoff + m * 2048 + k * 1024); } while (0)
#define PG8_LDB(dst, b, h) do { _Pragma("unroll") for (int n = 0; n < 2; ++n) _Pragma("unroll") for (int k = 0; k < 2; ++k) dst[n][k] = *(const PG8_LAS bf16x8*)(lds + PG8_SB(b, h) + boff + n * 2048 + k * 1024); } while (0)
#define PG8_MMA(ai, bj, At, Bt) do { __builtin_amdgcn_s_setprio(1); _Pragma("unroll") for (int m = 0; m < 4; ++m) _Pragma("unroll") for (int n = 0; n < 2; ++n) _Pragma("unroll") for (int k = 0; k < 2; ++k) \
        acc[ai][bj][m][n] = __builtin_amdgcn_mfma_f32_16x16x32_bf16(Bt[n][k], At[m][k], acc[ai][bj][m][n], 0, 0, 0); __builtin_amdgcn_s_setprio(0); } while (0)
#define PG8_WAIT_V(n) asm volatile("s_waitcnt vmcnt(" #n ")" ::: "memory")
#define PG8_WAIT_L(n) asm volatile("s_waitcnt lgkmcnt(" #n ")" ::: "memory")
#define PG8_BAR __builtin_amdgcn_s_barrier()
#define PG8_SCHED __builtin_amdgcn_sched_barrier(0)
    Unit cur, nxt; int ui = 0;
    if (!S.next(0, cur)) return;
    f32x4 acc[2][2][4][2];
#pragma unroll
    for (int a = 0; a < 2; ++a)
#pragma unroll
        for (int b = 0; b < 2; ++b)
#pragma unroll
            for (int m = 0; m < 4; ++m)
#pragma unroll
                for (int n = 0; n < 2; ++n) acc[a][b][m][n] = (f32x4){0.f, 0.f, 0.f, 0.f};
    bf16x8 At[4][2], B0[2][2], B1[2][2];
    const char* cA = (const char*)g.A + (size_t)cur.pm * tstep + (size_t)cur.k0 * 2; const char* cB = (const char*)g.Bt + (size_t)cur.pn * tstep + (size_t)cur.k0 * 2;
    S.a_ready(cur);
    if constexpr (SP2) {
        PG8_STAGE(PG8_SB(0, 0), cB, voffB); PG8_STAGE(PG8_SB(0, 1), cB + hstep, voffB); PG8_STAGE(PG8_SA(0, 0), cA, voffA); PG8_STAGE(PG8_SA(0, 1), cA + hstep, voffA);
        if (wr == 1) PG8_BAR;
        PG8_WAIT_V(2); PG8_BAR;
        PG8_STAGE(PG8_SB(1, 0), cB + kstep, voffB); PG8_STAGE(PG8_SA(1, 0), cA + kstep, voffA); PG8_STAGE(PG8_SB(1, 1), cB + hstep + kstep, voffB);
        PG8_WAIT_V(6); PG8_BAR;
    } else {
        PG8_STAGE(PG8_SB(0, 0), cB, voffB); PG8_STAGE(PG8_SA(0, 0), cA, voffA); PG8_STAGE(PG8_SB(0, 1), cB + hstep, voffB); PG8_STAGE(PG8_SA(0, 1), cA + hstep, voffA);
        if (wr == 1) PG8_BAR;
        PG8_WAIT_V(4); PG8_BAR;
        PG8_STAGE(PG8_SB(1, 0), cB + kstep, voffB); PG8_STAGE(PG8_SA(1, 0), cA + kstep, voffA); PG8_STAGE(PG8_SB(1, 1), cB + hstep + kstep, voffB);
        PG8_WAIT_V(6); PG8_BAR;
    }
    for (;;) {
        const bool has_next = S.next(ui + 1, nxt);
        const char* nA = has_next ? (const char*)g.A + (size_t)nxt.pm * tstep + (size_t)nxt.k0 * 2 : cA; const char* nB = has_next ? (const char*)g.Bt + (size_t)nxt.pn * tstep + (size_t)nxt.k0 * 2 : cB;
        for (int t = 0; t < nt; t += 2) {
            const bool last = (t == nt - 2);
            const char* a1 = cA + (size_t)(t + 1) * kstep;
            const char* a2 = last ? nA : cA + (size_t)(t + 2) * kstep; const char* b2 = last ? nB : cB + (size_t)(t + 2) * kstep;
            const char* a3 = a2 + kstep; const char* b3 = b2 + kstep;
            if (last && has_next) S.a_ready(nxt);
            if constexpr (SP2) {
            PG8_LDB(B0, 0, 0); PG8_LDB(B1, 0, 1); PG8_SCHED; PG8_LDA(At, 0, 0); PG8_STAGE(PG8_SA(1, 1), a1 + hstep, voffA);
            PG8_WAIT_V(8); PG8_WAIT_L(0); PG8_BAR; PG8_MMA(0, 0, At, B0); PG8_MMA(0, 1, At, B1); PG8_BAR; PG8_SCHED;
            PG8_LDA(At, 0, 1); PG8_STAGE(PG8_SB(0, 0), b2, voffB); PG8_STAGE(PG8_SB(0, 1), b2 + hstep, voffB); PG8_STAGE(PG8_SA(0, 0), a2, voffA);
            PG8_WAIT_V(8); PG8_WAIT_L(0); PG8_BAR; PG8_MMA(1, 0, At, B0); PG8_MMA(1, 1, At, B1); PG8_BAR; PG8_SCHED;
            PG8_LDB(B0, 1, 0); PG8_LDB(B1, 1, 1); PG8_SCHED; PG8_LDA(At, 1, 0); PG8_STAGE(PG8_SA(0, 1), a2 + hstep, voffA);
            PG8_WAIT_V(8); PG8_WAIT_L(0); PG8_BAR; PG8_MMA(0, 0, At, B0); PG8_MMA(0, 1, At, B1); PG8_BAR; PG8_SCHED;
            PG8_LDA(At, 1, 1); PG8_STAGE(PG8_SB(1, 0), b3, voffB); PG8_STAGE(PG8_SB(1, 1), b3 + hstep, voffB); PG8_STAGE(PG8_SA(1, 0), a3, voffA);
            PG8_WAIT_V(8); PG8_WAIT_L(0); PG8_BAR; PG8_MMA(1, 0, At, B0); PG8_MMA(1, 1, At, B1); PG8_BAR; PG8_SCHED;
            } else {
            PG8_LDB(B0, 0, 0); PG8_SCHED; PG8_LDA(At, 0, 0); PG8_STAGE(PG8_SA(1, 1), a1 + hstep, voffA);
            PG8_WAIT_L(8); PG8_BAR; PG8_WAIT_L(0); PG8_MMA(0, 0, At, B0); PG8_BAR; PG8_SCHED;
            PG8_LDB(B1, 0, 1); PG8_STAGE(PG8_SB(0, 0), b2, voffB);
            PG8_BAR; PG8_WAIT_L(0); PG8_MMA(0, 1, At, B1); PG8_BAR;
            PG8_LDA(At, 0, 1); PG8_STAGE(PG8_SA(0, 0), a2, voffA);
            PG8_BAR; PG8_WAIT_L(0); PG8_MMA(1, 0, At, B0); PG8_BAR; PG8_SCHED;
            PG8_STAGE(PG8_SB(0, 1), b2 + hstep, voffB);
            PG8_WAIT_V(6); PG8_BAR; PG8_MMA(1, 1, At, B1); PG8_BAR;
            PG8_LDB(B0, 1, 0); PG8_SCHED; PG8_LDA(At, 1, 0); PG8_STAGE(PG8_SA(0, 1), a2 + hstep, voffA);
            PG8_WAIT_L(8); PG8_BAR; PG8_WAIT_L(0); PG8_MMA(0, 0, At, B0); PG8_BAR; PG8_SCHED;
            PG8_LDB(B1, 1, 1); PG8_STAGE(PG8_SB(1, 0), b3, voffB);
            PG8_BAR; PG8_WAIT_L(0); PG8_MMA(0, 1, At, B1); PG8_BAR;
            PG8_LDA(At, 1, 1); PG8_STAGE(PG8_SA(1, 0), a3, voffA);
            PG8_BAR; PG8_WAIT_L(0); PG8_MMA(1, 0, At, B0); PG8_BAR; PG8_SCHED;
            PG8_STAGE(PG8_SB(1, 1), b3 + hstep, voffB);
            PG8_WAIT_V(6); PG8_BAR; PG8_MMA(1, 1, At, B1); PG8_BAR;
            }
        }
        if constexpr (ALIGN_EPI) { if (wr == 0) PG8_BAR; }
        if constexpr (!Epi::AFTER_DRAIN) { E(acc, cur, wr, wc, fr, fq); S.done(cur); }
        if (!has_next) break;
#pragma unroll
        for (int a = 0; a < 2; ++a)
#pragma unroll
            for (int b = 0; b < 2; ++b)
#pragma unroll
                for (int m = 0; m < 4; ++m)
#pragma unroll
                    for (int n = 0; n < 2; ++n) acc[a][b][m][n] = (f32x4){0.f, 0.f, 0.f, 0.f};
        cur = nxt; cA = nA; cB = nB; ++ui;
        if constexpr (ALIGN_EPI) { if (wr == 1) PG8_BAR; }
    }
    PG8_WAIT_V(0);
    if constexpr (!ALIGN_EPI) { if (wr == 0) PG8_BAR; }
    PG8_BAR;
    if constexpr (Epi::AFTER_DRAIN) { E.fused(acc, cur, wr, wc, fr, fq, lds, wid, lane); S.done(cur); }
#undef PG8_SA
#undef PG8_SB
#undef PG8_STAGE
#undef PG8_LDA
#undef PG8_LDB
#undef PG8_MMA
#undef PG8_WAIT_V
#undef PG8_WAIT_L
#undef PG8_BAR
#undef PG8_SCHED
}
}

namespace att {
#define ALAS __attribute__((address_space(3)))
typedef unsigned short bf16_t;
typedef short bf16x8 __attribute__((ext_vector_type(8)));
typedef short s16x4 __attribute__((ext_vector_type(4)));
typedef float f32x16 __attribute__((ext_vector_type(16)));
typedef float f32x4 __attribute__((ext_vector_type(4)));
typedef float f32x2_t __attribute__((ext_vector_type(2)));
typedef __bf16 bf16x2_t __attribute__((ext_vector_type(2)));
typedef unsigned u32x4 __attribute__((ext_vector_type(4)));
typedef unsigned u32x2 __attribute__((ext_vector_type(2)));
typedef short v4i16_t __attribute__((ext_vector_type(4)));
constexpr int TILE_B = 16384;
constexpr int STG_K = 0, STG_V = 2 * TILE_B, STG_B = 4 * TILE_B;
__device__ __forceinline__ int crow(int r, int h) { return (r & 3) + 8 * (r >> 2) + 4 * h; }
__device__ __forceinline__ unsigned cvtpk(float lo, float hi) { f32x2_t v = {lo, hi}; bf16x2_t b = __builtin_convertvector(v, bf16x2_t); return __builtin_bit_cast(unsigned, b); }
__device__ __forceinline__ float half_max(float v) { auto rr = __builtin_amdgcn_permlane32_swap(__float_as_uint(v), __float_as_uint(v), false, false); return fmaxf(__uint_as_float(rr[0]), __uint_as_float(rr[1])); }
__device__ __forceinline__ float half_sum(float v) { auto rr = __builtin_amdgcn_permlane32_swap(__float_as_uint(v), __float_as_uint(v), false, false); return __uint_as_float(rr[0]) + __uint_as_float(rr[1]); }
__device__ __forceinline__ s16x4 vtr(const ALAS unsigned char* p) { return __builtin_bit_cast(s16x4, __builtin_amdgcn_ds_read_tr16_b64_v4i16((ALAS v4i16_t*)p)); }

struct UnitDesc { const bf16_t* Q; const bf16_t* K; const bf16_t* V; bf16_t* O; int q0pos, nvalid, kv_len, s_hi, s_lo; float slope2; };

__device__ __forceinline__ void attn_unit(ALAS unsigned char* lds, const UnitDesc d, const float lam, const float* __restrict__ subg) {
    int tid = threadIdx.x; asm volatile("" : "+v"(tid));
    const int lane = tid & 63, w = __builtin_amdgcn_readfirstlane(tid >> 6), c = w >> 2, j = w & 3, r32 = lane & 31, hh = lane >> 5;
    const bool active = (32 * j < d.nvalid);
    const int qw0 = d.q0pos + 32 * j;
    const int td = active ? (qw0 >> 6) : -1;
    const int lrow = lane >> 4; const unsigned fsw = (((unsigned)lrow & 3u) << 2) | ((unsigned)w & 3u); const int gch = (int)(((unsigned)lane & 15u) ^ fsw);
    const bf16_t* kg = d.K + (size_t)(4 * w + lrow) * HW + gch * 8;
    const bf16_t* vg = d.V + (size_t)(4 * w + lrow) * HW + gch * 8;
#define ATT_DMA(s_, buf_) do { const size_t go_ = (size_t)(s_) * 128 * HW; ALAS unsigned char* lb_ = lds + (buf_) * STG_B + w * 1024; \
        _Pragma("unroll") for (int i_ = 0; i_ < 4; ++i_) { \
        __builtin_amdgcn_global_load_lds((const unsigned*)(kg + go_ + (size_t)i_ * 32 * HW), (ALAS unsigned*)(lb_ + STG_K + i_ * 8192), 16, 0, 0); \
        __builtin_amdgcn_global_load_lds((const unsigned*)(vg + go_ + (size_t)i_ * 32 * HW), (ALAS unsigned*)(lb_ + STG_V + i_ * 8192), 16, 0, 0); } } while (0)
    bf16x8 qf[4];
#pragma unroll
    for (int s = 0; s < 4; ++s) { if (active) qf[s] = *(const bf16x8*)(d.Q + (size_t)(32 * j + r32) * HW + c * 64 + 16 * s + 8 * hh); else qf[s] = (bf16x8){0, 0, 0, 0, 0, 0, 0, 0}; }
    unsigned koff[4];
    { const unsigned f = ((r32 & 3u) << 2) | ((r32 >> 2) & 3u);
#pragma unroll
      for (int s = 0; s < 4; ++s) koff[s] = 256u * r32 + 16u * (((unsigned)(8 * c + 2 * s + hh)) ^ f); }
    unsigned voff[2][4];
    { const unsigned qq = (lane & 15) >> 2, p = lane & 3, blk = (lane >> 4) & 1;
#pragma unroll
      for (int tt = 0; tt < 2; ++tt)
#pragma unroll
          for (int c4 = 0; c4 < 4; ++c4)
              voff[tt][c4] = 256u * (8 * tt + 4 * hh + qq) + 16u * ((((unsigned)c4 ^ qq) << 2) | (((2 * blk + (p >> 1)) ^ (unsigned)(2 * tt + hh)) & 3u)) + 8u * (p & 1); }
    float mref = 0.f, lsum = 0.f;
    f32x16 o[4];
#pragma unroll
    for (int c4 = 0; c4 < 4; ++c4)
#pragma unroll
        for (int i = 0; i < 16; ++i) o[c4][i] = 0.f;

    const int NI = d.s_hi - d.s_lo + 1;
    ATT_DMA(d.s_lo, 0);
    for (int it = 0; it + 1 < NI; ++it) {
        const int sg = d.s_lo + it;
        asm volatile("s_waitcnt vmcnt(0)" ::: "memory"); __syncthreads();
        ATT_DMA(sg + 1, (it + 1) & 1);
        const ALAS unsigned char* Sb = lds + (it & 1) * STG_B;
#define ATT_SB() __builtin_amdgcn_sched_barrier(0)
#define ATT_KLD(Kb_) do { _Pragma("unroll") for (int s = 0; s < 4; ++s) { kf[2 * s] = *(const ALAS bf16x8*)((Kb_) + koff[s]); kf[2 * s + 1] = *(const ALAS bf16x8*)((Kb_) + koff[s] + 8192); } } while (0)
#define ATT_QK(x0_, x1_) do { _Pragma("unroll") for (int s = 0; s < 4; ++s) { x0_ = __builtin_amdgcn_mfma_f32_32x32x16_bf16(kf[2 * s], qf[s], x0_, 0, 0, 0); x1_ = __builtin_amdgcn_mfma_f32_32x32x16_bf16(kf[2 * s + 1], qf[s], x1_, 0, 0, 0); } } while (0)
#define ATT_VLD2(bsel_, Vb_, ks_) do { _Pragma("unroll") for (int c4 = 0; c4 < 4; ++c4) { vl[bsel_][c4] = vtr((Vb_) + voff[0][c4] + 4096 * (ks_)); vh[bsel_][c4] = vtr((Vb_) + voff[1][c4] + 4096 * (ks_)); } } while (0)
#define ATT_PVK(ks_, pf_) do { _Pragma("unroll") for (int c4 = 0; c4 < 4; ++c4) { const s16x4 lo = vl[(ks_) & 1][c4], hi = vh[(ks_) & 1][c4]; \
            const bf16x8 vt = (bf16x8){lo[0], lo[1], lo[2], lo[3], hi[0], hi[1], hi[2], hi[3]}; o[c4] = __builtin_amdgcn_mfma_f32_32x32x16_bf16(vt, pf_[ks_], o[c4], 0, 0, 0); } } while (0)
#define ATT_SOFTMAX(x0_, x1_, pf_) do { float ps_ = 0.f; \
            _Pragma("unroll") for (int i = 0; i < 16; ++i) { x0_[i] = __builtin_amdgcn_exp2f(x0_[i]); x1_[i] = __builtin_amdgcn_exp2f(x1_[i]); } \
            _Pragma("unroll") for (int i = 0; i < 16; i += 2) pm = fmaxf(fmaxf(pm, fmaxf(x0_[i], x0_[i + 1])), fmaxf(x1_[i], x1_[i + 1])); \
            _Pragma("unroll") for (int i = 0; i < 16; ++i) ps_ += x0_[i] + x1_[i]; \
            lsum += ps_; \
            _Pragma("unroll") for (int s = 0; s < 2; ++s) { u32x4 a_, b_; \
                a_.x = cvtpk(x0_[8 * s], x0_[8 * s + 1]); a_.y = cvtpk(x0_[8 * s + 2], x0_[8 * s + 3]); a_.z = cvtpk(x0_[8 * s + 4], x0_[8 * s + 5]); a_.w = cvtpk(x0_[8 * s + 6], x0_[8 * s + 7]); \
                b_.x = cvtpk(x1_[8 * s], x1_[8 * s + 1]); b_.y = cvtpk(x1_[8 * s + 2], x1_[8 * s + 3]); b_.z = cvtpk(x1_[8 * s + 4], x1_[8 * s + 5]); b_.w = cvtpk(x1_[8 * s + 6], x1_[8 * s + 7]); \
                pf_[s] = __builtin_bit_cast(bf16x8, a_); pf_[2 + s] = __builtin_bit_cast(bf16x8, b_); } } while (0)
        if (active) {
            const ALAS unsigned char* K0 = Sb + STG_K; const ALAS unsigned char* V0 = Sb + STG_V;
            f32x16 a0, a1, b0, b1;
            { const float c0 = d.slope2 * (float)(128 * sg - qw0 + 4 * hh) - mref, st = 32.f * d.slope2;
#pragma unroll
              for (int i = 0; i < 16; ++i) { const float ci = (float)((i & 3) + 8 * (i >> 2));
                  a0[i] = __builtin_fmaf(d.slope2, ci, c0); a1[i] = __builtin_fmaf(d.slope2, ci, c0 + st); b0[i] = __builtin_fmaf(d.slope2, ci, c0 + 2.f * st); b1[i] = __builtin_fmaf(d.slope2, ci, c0 + 3.f * st); } }
            bf16x8 kf[8]; s16x4 vl[2][4], vh[2][4]; bf16x8 pfA[4], pfB[4]; float pm = 0.f;
            ATT_KLD(K0); ATT_SB();
            ATT_QK(a0, a1);
            ATT_KLD(K0 + TILE_B); ATT_SB();
            ATT_QK(b0, b1);
            ATT_SOFTMAX(a0, a1, pfA);
#pragma unroll
            for (int g = 0; g < 8; ++g) { __builtin_amdgcn_sched_group_barrier(0x008, 1, 0); __builtin_amdgcn_sched_group_barrier(0x400, 4, 0); __builtin_amdgcn_sched_group_barrier(0x002, 9, 0); }
            ATT_SB();
            ATT_VLD2(0, V0, 0); ATT_VLD2(1, V0, 1); ATT_SB();
            float psB = 0.f;
#define ATT_SM_CHUNK(k_) do { _Pragma("unroll") for (int i = 4 * (k_); i < 4 * (k_) + 4; ++i) { b0[i] = __builtin_amdgcn_exp2f(b0[i]); b1[i] = __builtin_amdgcn_exp2f(b1[i]); } \
            pm = fmaxf(fmaxf(pm, fmaxf(b0[4 * (k_)], b0[4 * (k_) + 1])), fmaxf(b0[4 * (k_) + 2], b0[4 * (k_) + 3])); pm = fmaxf(fmaxf(pm, fmaxf(b1[4 * (k_)], b1[4 * (k_) + 1])), fmaxf(b1[4 * (k_) + 2], b1[4 * (k_) + 3])); \
            psB += (b0[4 * (k_)] + b0[4 * (k_) + 1]) + (b0[4 * (k_) + 2] + b0[4 * (k_) + 3]) + (b1[4 * (k_)] + b1[4 * (k_) + 1]) + (b1[4 * (k_) + 2] + b1[4 * (k_) + 3]); } while (0)
#define ATT_PIPE4() do { _Pragma("unroll") for (int g = 0; g < 4; ++g) { __builtin_amdgcn_sched_group_barrier(0x008, 1, 2); __builtin_amdgcn_sched_group_barrier(0x400, 2, 2); __builtin_amdgcn_sched_group_barrier(0x002, 4, 2); } } while (0)
            ATT_PVK(0, pfA); ATT_SM_CHUNK(0); ATT_VLD2(0, V0, 2); ATT_PIPE4(); ATT_SB();
            ATT_PVK(1, pfA); ATT_SM_CHUNK(1); ATT_VLD2(1, V0, 3); ATT_PIPE4(); ATT_SB();
            ATT_PVK(2, pfA); ATT_SM_CHUNK(2); ATT_VLD2(0, V0 + TILE_B, 0); ATT_PIPE4(); ATT_SB();
            ATT_PVK(3, pfA); ATT_SM_CHUNK(3); ATT_VLD2(1, V0 + TILE_B, 1);
            lsum += psB;
#pragma unroll
            for (int s2 = 0; s2 < 2; ++s2) { u32x4 a_, b_;
                a_.x = cvtpk(b0[8 * s2], b0[8 * s2 + 1]); a_.y = cvtpk(b0[8 * s2 + 2], b0[8 * s2 + 3]); a_.z = cvtpk(b0[8 * s2 + 4], b0[8 * s2 + 5]); a_.w = cvtpk(b0[8 * s2 + 6], b0[8 * s2 + 7]);
                b_.x = cvtpk(b1[8 * s2], b1[8 * s2 + 1]); b_.y = cvtpk(b1[8 * s2 + 2], b1[8 * s2 + 3]); b_.z = cvtpk(b1[8 * s2 + 4], b1[8 * s2 + 5]); b_.w = cvtpk(b1[8 * s2 + 6], b1[8 * s2 + 7]);
                pfB[s2] = __builtin_bit_cast(bf16x8, a_); pfB[2 + s2] = __builtin_bit_cast(bf16x8, b_); }
#pragma unroll
            for (int g = 0; g < 4; ++g) { __builtin_amdgcn_sched_group_barrier(0x008, 1, 3); __builtin_amdgcn_sched_group_barrier(0x400, 2, 3); __builtin_amdgcn_sched_group_barrier(0x002, 8, 3); }
            ATT_SB();
            ATT_PVK(0, pfB); ATT_VLD2(0, V0 + TILE_B, 2); ATT_SB();
            ATT_PVK(1, pfB); ATT_VLD2(1, V0 + TILE_B, 3); ATT_SB();
            ATT_PVK(2, pfB);
            ATT_PVK(3, pfB);
            ATT_SB();
#undef ATT_SM_CHUNK
#undef ATT_PIPE4
            if (__builtin_expect(__any(pm > 256.f), 0)) {
                pm = half_max(pm);
                const float dl = pm > 1.f ? ceilf(__builtin_amdgcn_logf(pm)) : 0.f, f = __builtin_amdgcn_exp2f(-dl);
                mref += dl; lsum *= f;
#pragma unroll
                for (int c4 = 0; c4 < 4; ++c4)
#pragma unroll
                    for (int i = 0; i < 16; ++i) o[c4][i] *= f;
            }
        }
    }
    {
        const int it = NI - 1, sg = d.s_hi;
        asm volatile("s_waitcnt vmcnt(0)" ::: "memory"); __syncthreads();
        const ALAS unsigned char* Sb = lds + (it & 1) * STG_B;
#pragma unroll
        for (int tau = 0; tau < 2; ++tau) {
            const int t = 2 * sg + tau;
            if (t <= td) {
                const ALAS unsigned char* Kb = Sb + STG_K + tau * TILE_B; const ALAS unsigned char* Vb = Sb + STG_V + tau * TILE_B;
                f32x16 s0, s1;
                if (t == td) {
                    const int qpos = qw0 + r32; const float rc = d.slope2 * (float)r32 - mref;
#pragma unroll
                    for (int i = 0; i < 16; ++i) { const int k0 = 64 * t + crow(i, hh), k1 = k0 + 32;
                        const int d0 = qpos - k0, d1 = qpos - k1;
                        s0[i] = k0 < d.kv_len ? rc - d.slope2 * (float)(d0 < 0 ? -d0 : d0) : -1e30f;
                        s1[i] = k1 < d.kv_len ? rc - d.slope2 * (float)(d1 < 0 ? -d1 : d1) : -1e30f; }
                } else {
                    const float b0 = d.slope2 * (float)(64 * t - qw0 + 4 * hh) - mref, b1 = b0 + 32.f * d.slope2;
#pragma unroll
                    for (int i = 0; i < 16; ++i) { const float ci = (float)((i & 3) + 8 * (i >> 2)); s0[i] = __builtin_fmaf(d.slope2, ci, b0); s1[i] = __builtin_fmaf(d.slope2, ci, b1); }
                }
                bf16x8 kf[8];
#pragma unroll
                for (int s = 0; s < 4; ++s) { kf[2 * s] = *(const ALAS bf16x8*)(Kb + koff[s]); kf[2 * s + 1] = *(const ALAS bf16x8*)(Kb + koff[s] + 8192); }
                __builtin_amdgcn_sched_barrier(0);
#pragma unroll
                for (int s = 0; s < 4; ++s) {
                    s0 = __builtin_amdgcn_mfma_f32_32x32x16_bf16(kf[2 * s], qf[s], s0, 0, 0, 0);
                    s1 = __builtin_amdgcn_mfma_f32_32x32x16_bf16(kf[2 * s + 1], qf[s], s1, 0, 0, 0);
                }
                s16x4 vl[2][4], vh[2][4];
#define ATT_VLD(bsel_, ks_) do { _Pragma("unroll") for (int c4 = 0; c4 < 4; ++c4) { vl[bsel_][c4] = vtr(Vb + voff[0][c4] + 4096 * (ks_)); vh[bsel_][c4] = vtr(Vb + voff[1][c4] + 4096 * (ks_)); } } while (0)
                ATT_VLD(0, 0);
                __builtin_amdgcn_sched_barrier(0);
                float pm = 0.f, ps = 0.f;
#pragma unroll
                for (int i = 0; i < 16; ++i) { s0[i] = __builtin_amdgcn_exp2f(s0[i]); s1[i] = __builtin_amdgcn_exp2f(s1[i]); }
#pragma unroll
                for (int i = 0; i < 16; i += 2) pm = fmaxf(fmaxf(pm, fmaxf(s0[i], s0[i + 1])), fmaxf(s1[i], s1[i + 1]));
                if (__builtin_expect(__any(pm > 256.f), 0)) {
                    pm = half_max(pm);
                    const float dl = pm > 1.f ? ceilf(__builtin_amdgcn_logf(pm)) : 0.f, f = __builtin_amdgcn_exp2f(-dl);
                    mref += dl; lsum *= f;
#pragma unroll
                    for (int i = 0; i < 16; ++i) { s0[i] *= f; s1[i] *= f; }
#pragma unroll
                    for (int c4 = 0; c4 < 4; ++c4)
#pragma unroll
                        for (int i = 0; i < 16; ++i) o[c4][i] *= f;
                }
#pragma unroll
                for (int i = 0; i < 16; ++i) ps += s0[i] + s1[i];
                lsum += ps;
                bf16x8 pf[4];
#pragma unroll
                for (int s = 0; s < 2; ++s) {
                    u32x4 a, b;
                    a.x = cvtpk(s0[8 * s], s0[8 * s + 1]); a.y = cvtpk(s0[8 * s + 2], s0[8 * s + 3]); a.z = cvtpk(s0[8 * s + 4], s0[8 * s + 5]); a.w = cvtpk(s0[8 * s + 6], s0[8 * s + 7]);
                    b.x = cvtpk(s1[8 * s], s1[8 * s + 1]); b.y = cvtpk(s1[8 * s + 2], s1[8 * s + 3]); b.z = cvtpk(s1[8 * s + 4], s1[8 * s + 5]); b.w = cvtpk(s1[8 * s + 6], s1[8 * s + 7]);
                    pf[s] = __builtin_bit_cast(bf16x8, a); pf[2 + s] = __builtin_bit_cast(bf16x8, b);
                }
#pragma unroll
                for (int ks = 0; ks < 4; ++ks) {
                    if (ks < 3) ATT_VLD((ks + 1) & 1, ks + 1);
                    __builtin_amdgcn_sched_barrier(0);
#pragma unroll
                    for (int c4 = 0; c4 < 4; ++c4) {
                        const s16x4 lo = vl[ks & 1][c4], hi = vh[ks & 1][c4];
                        const bf16x8 vt = (bf16x8){lo[0], lo[1], lo[2], lo[3], hi[0], hi[1], hi[2], hi[3]};
                        o[c4] = __builtin_amdgcn_mfma_f32_32x32x16_bf16(vt, pf[ks], o[c4], 0, 0, 0);
                    }
                    __builtin_amdgcn_sched_barrier(0);
                }
#undef ATT_VLD
            }
        }
    }
    __syncthreads();
    const float ltot = half_sum(lsum), inv = active ? 1.f / ltot : 0.f;
    ALAS float* xch = (ALAS float*)lds + j * 4096;
    if (c == 1 && active) {
#pragma unroll
        for (int c4 = 0; c4 < 4; ++c4)
#pragma unroll
            for (int i = 0; i < 16; ++i) xch[(c4 * 16 + i) * 64 + lane] = o[c4][i] * inv;
    }
    __syncthreads();
    if (c == 0 && active) {
        float ss = 0.f;
#pragma unroll
        for (int c4 = 0; c4 < 4; ++c4)
#pragma unroll
            for (int i = 0; i < 16; ++i) { const float v = o[c4][i] * inv - lam * xch[(c4 * 16 + i) * 64 + lane]; o[c4][i] = v; ss += v * v; }
        ss = half_sum(ss);
        const float rs = 0.8f / sqrtf(ss * (1.f / 128.f) + EPS);
        bf16_t* op = d.O + (size_t)(32 * j + r32) * DM + 4 * hh;
#pragma unroll
        for (int c4 = 0; c4 < 4; ++c4)
#pragma unroll
            for (int g4 = 0; g4 < 4; ++g4) { const int dv0 = 32 * c4 + 8 * g4;
                const f32x4 g = *(const f32x4*)(subg + dv0 + 4 * hh);
                u32x2 pk; pk.x = cvtpk(o[c4][4 * g4] * rs * g[0], o[c4][4 * g4 + 1] * rs * g[1]); pk.y = cvtpk(o[c4][4 * g4 + 2] * rs * g[2], o[c4][4 * g4 + 3] * rs * g[3]);
                *(u32x2*)(op + dv0) = pk; }
    }
    __syncthreads();
}
#undef ATT_DMA
#undef ATT_SB
#undef ATT_KLD
#undef ATT_QK
#undef ATT_VLD2
#undef ATT_PVK
#undef ATT_SOFTMAX
#undef ALAS
}

#define GAS __attribute__((address_space(1)))
#define LAS __attribute__((address_space(3)))
typedef unsigned short bf16;
typedef unsigned v4u __attribute__((ext_vector_type(4)));
typedef unsigned v2u __attribute__((ext_vector_type(2)));
typedef float f32x4 __attribute__((ext_vector_type(4)));
constexpr int NWAVES = 8, NTHREADS = 512;
constexpr int LDS_BYTES = 147456;
constexpr size_t MiB = 1u << 20;
constexpr size_t WS_MOD = 0;
constexpr size_t WS_QCTR = 1 * MiB + 16384, WS_MAXB = 1 * MiB + 32768;
constexpr size_t WS_BAR = 1 * MiB;
constexpr size_t WS_ROWSS = 1 * MiB + 65536;
constexpr size_t WS_SH2 = 30 * MiB;
constexpr size_t WS_BIAS2 = 26 * MiB;
constexpr size_t CTL_BYTES = 65536 + (size_t)MT * 4;
constexpr int MISC_OFF = 131072 + 320;
constexpr size_t WS_WIN = 2 * MiB, WS_WO = 8 * MiB, WS_W1 = 10 * MiB, WS_W2 = 18 * MiB;
constexpr size_t WS_XN = 32 * MiB;
constexpr size_t WS_HB = 192 * MiB;
constexpr size_t WS_BG = 192 * MiB, WS_CG = 257 * MiB, WS_UG = 322 * MiB, WS_QB = 387 * MiB;
constexpr size_t WS_KB = 452 * MiB, WS_VB = 550 * MiB;
constexpr size_t WS_MIX = 648 * MiB;
constexpr size_t WS_END = 778 * MiB;
static_assert((size_t)MT * HW * 2 <= 65 * MiB && (size_t)KVROWS * HW * 2 <= 98 * MiB && (size_t)MT * DM * 2 <= 130 * MiB && (size_t)MT * FF * 2 <= 520 * MiB, "ws map");

__device__ __forceinline__ unsigned f2bf(float f) { unsigned u = __builtin_bit_cast(unsigned, f); return (u + 0x7fffu + ((u >> 16) & 1u)) >> 16; }
__device__ __forceinline__ unsigned pk2(float lo, float hi) { return f2bf(lo) | (f2bf(hi) << 16); }
__device__ __forceinline__ float bflo(unsigned u) { return __builtin_bit_cast(float, u << 16); }
__device__ __forceinline__ float bfhi(unsigned u) { return __builtin_bit_cast(float, u & 0xffff0000u); }
__device__ __forceinline__ float wave_sum(float v) {
    v += __builtin_bit_cast(float, __builtin_amdgcn_update_dpp(0, __builtin_bit_cast(int, v), 0xB1, 0xf, 0xf, true));
    v += __builtin_bit_cast(float, __builtin_amdgcn_update_dpp(0, __builtin_bit_cast(int, v), 0x4E, 0xf, 0xf, true));
    v += __builtin_bit_cast(float, __builtin_amdgcn_update_dpp(0, __builtin_bit_cast(int, v), 0x141, 0xf, 0xf, true));
    v += __builtin_bit_cast(float, __builtin_amdgcn_update_dpp(0, __builtin_bit_cast(int, v), 0x140, 0xf, 0xf, true));
    { auto r = __builtin_amdgcn_permlane16_swap(__float_as_uint(v), __float_as_uint(v), false, false); v = __uint_as_float(r[0]) + __uint_as_float(r[1]); }
    { auto r = __builtin_amdgcn_permlane32_swap(__float_as_uint(v), __float_as_uint(v), false, false); v = __uint_as_float(r[0]) + __uint_as_float(r[1]); }
    return v;
}
#define LDS_WAIT() asm volatile("s_waitcnt lgkmcnt(0)" ::: "memory")

#define XB_TMO      128
#define XB_XCNT(j)  (256  + 64 * (j))
#define XB_XSUB(j)  (1280 + 64 * (j))
#define XB_XGEN(j)  (2304 + 64 * (j))
#define XB_TOP      3328
#define XB_TOPGEN   3392
#define XCD_BAR_WORDS 3456
#define XB_SPIN_CAP (1u << 18)

__device__ __forceinline__ unsigned xb_ld(unsigned* p)              { return __hip_atomic_load(p, __ATOMIC_RELAXED, __HIP_MEMORY_SCOPE_AGENT); }
__device__ __forceinline__ unsigned xb_add(unsigned* p, unsigned v) { return __hip_atomic_fetch_add(p, v, __ATOMIC_RELAXED, __HIP_MEMORY_SCOPE_AGENT); }
__device__ __forceinline__ unsigned xb_xcc_id() { return (unsigned)__builtin_amdgcn_s_getreg((3 << 11) | 20) & 0xFu; }
#define XB_SPIN(cond, bar) do { unsigned _sp = 0; while (cond) { __builtin_amdgcn_s_sleep(1); \
    if ((++_sp & 255u) == 0u) { if (xb_ld(&(bar)[XB_TMO])) break; if (_sp > XB_SPIN_CAP) { atomicAdd(&(bar)[XB_TMO], 1u); break; } } } } while (0)

struct XcdBarrier {
    unsigned* bar; unsigned x;
    volatile LAS unsigned* st;
};

__device__ __forceinline__ XcdBarrier xcd_barrier_post(unsigned* bar, volatile LAS unsigned* st) {
    XcdBarrier b; b.bar = bar; b.x = xb_xcc_id(); b.st = st;
    if (threadIdx.x == 0) (void)xb_add(&bar[XB_XCNT(b.x)], 1u);
    return b;
}
__device__ __forceinline__ void xcd_barrier_complete(unsigned* bar, unsigned x, unsigned& nloc, unsigned& nx) {
    const unsigned G = gridDim.x * gridDim.y * gridDim.z;
    unsigned sum, cnt, mine, sp = 0u;
    for (;;) {
        sum = 0u; cnt = 0u; mine = 0u;
#pragma unroll
        for (unsigned j = 0; j < 16; ++j) { const unsigned c = xb_ld(&bar[XB_XCNT(j)]); sum += c; cnt += (c > 0u) ? 1u : 0u; mine = (j == x) ? c : mine; }
        if (sum == G) break;
        __builtin_amdgcn_s_sleep(1);
        if ((++sp & 255u) == 0u) { if (xb_ld(&bar[XB_TMO])) break; if (sp > XB_SPIN_CAP) { atomicAdd(&bar[XB_TMO], 1u); break; } }
    }
    nloc = mine > 0u ? mine : 1u; nx = cnt > 0u ? cnt : 1u;
}

__device__ __forceinline__ void xcd_barrier(const XcdBarrier& b) {
    asm volatile("s_waitcnt vmcnt(0)" ::: "memory");
    __syncthreads();
    if (threadIdx.x == 0) {
        unsigned* bar = b.bar;
        __builtin_amdgcn_s_waitcnt(0);
        unsigned nloc = b.st[0], nx = b.st[1];
        if (nloc == 0u) { xcd_barrier_complete(bar, b.x, nloc, nx); b.st[0] = nloc; b.st[1] = nx; }
        const unsigned old = xb_add(&bar[XB_XSUB(b.x)], 1u);
        const unsigned gen = old / nloc;
        if (old + 1u == (gen + 1u) * nloc) {
            __builtin_amdgcn_fence(__ATOMIC_RELEASE, "agent");
            asm volatile("s_waitcnt vmcnt(0)" ::: "memory");
            const unsigned og = xb_add(&bar[XB_TOP], 1u);
            const unsigned tg = og / nx;
            if (og + 1u == (tg + 1u) * nx) xb_add(&bar[XB_TOPGEN], 1u);
            else XB_SPIN(xb_ld(&bar[XB_TOPGEN]) == tg, bar);
            __builtin_amdgcn_fence(__ATOMIC_ACQUIRE, "agent");
            xb_add(&bar[XB_XGEN(b.x)], 1u);
            asm volatile("s_waitcnt vmcnt(0)" ::: "memory");
        } else {
            XB_SPIN(xb_ld(&bar[XB_XGEN(b.x)]) == gen, bar);
            __builtin_amdgcn_fence(__ATOMIC_ACQUIRE, "agent");
            asm volatile("s_waitcnt vmcnt(0)" ::: "memory");
        }
    }
    __syncthreads();
}


struct Args {
    const float *x_p, *x_s, *cache_k, *cache_v, *state_conv, *c_p, *c_s, *norm1_g, *norm2_g, *w_ada, *b_ada, *w_in, *conv_w, *lq1, *lk1, *lq2, *lk2, *subln_g, *w_o, *w_mlp1, *w_mlp2, *final_g;
    float* out; unsigned char* ws; int never; int pad;
};

__device__ __forceinline__ void p0_transpose_item(const float* W, int K, int N, bf16* WT, LAS float* scr, int item, int lane) {
    const int nblk = N / 32, kb = item / nblk, nb = item % nblk, k0 = 64 * kb, n0 = 32 * nb;
    float wv[32];
#pragma unroll
    for (int i = 0; i < 32; ++i) wv[i] = W[(size_t)(k0 + 2 * i + (lane >> 5)) * N + n0 + (lane & 31)];
#pragma unroll
    for (int i = 0; i < 32; ++i) scr[(2 * i + (lane >> 5)) * 33 + (lane & 31)] = wv[i];
    LDS_WAIT(); asm volatile("" ::: "memory");
    const int c = lane & 7;
#pragma unroll
    for (int j = 0; j < 4; ++j) { const int n = (lane >> 3) + 8 * j; const LAS float* s = scr + (8 * c) * 33 + n;
        v4u o; o.x = pk2(s[0 * 33], s[1 * 33]); o.y = pk2(s[2 * 33], s[3 * 33]); o.z = pk2(s[4 * 33], s[5 * 33]); o.w = pk2(s[6 * 33], s[7 * 33]);
        *(GAS v4u*)(WT + (size_t)(n0 + n) * K + k0 + 8 * c) = o; }
    LDS_WAIT(); asm volatile("" ::: "memory");
}

__device__ __forceinline__ void norm_mod_row(const float* xrow, const float* g, const float* sc, const float* sh, bf16* orow, int lane) {
    const f32x4* xr = (const f32x4*)xrow + lane;
    f32x4 v[4]; float s = 0.f;
#pragma unroll
    for (int j = 0; j < 4; ++j) { v[j] = xr[64 * j]; s += (v[j].x * v[j].x + v[j].y * v[j].y) + (v[j].z * v[j].z + v[j].w * v[j].w); }
    const float rstd = 1.f / sqrtf(wave_sum(s) * (1.f / DM) + EPS);
    unsigned long long* o8 = (unsigned long long*)orow + lane;
#pragma unroll
    for (int j = 0; j < 4; ++j) { const f32x4 gg = ((const f32x4*)g)[lane + 64 * j], cc = ((const f32x4*)sc)[lane + 64 * j], hh = ((const f32x4*)sh)[lane + 64 * j];
        const f32x4 r = v[j] * rstd * gg * (cc + 1.f) + hh;
        o8[64 * j] = (unsigned long long)pk2(r.x, r.y) | ((unsigned long long)pk2(r.z, r.w) << 32); }
}

__global__ void __launch_bounds__(NTHREADS, 2) mega_fwd(Args a) {
    extern __shared__ __attribute__((aligned(16))) unsigned char lds_raw[];
    LAS unsigned char* lds = (LAS unsigned char*)lds_raw;
    cg::grid_group grid = cg::this_grid();
    const int G = gridDim.x; const int bx = blockIdx.x;
    const int vcu = (G % 8 == 0) ? (bx % 8) * (G / 8) + bx / 8 : bx;
    const int NGW = G * NWAVES;
#define PHASE_IDS() int tid_ = threadIdx.x; asm volatile("" : "+v"(tid_)); const int tid = tid_, lane = tid & 63, wave = __builtin_amdgcn_readfirstlane(tid >> 6), gw = vcu * NWAVES + wave; (void)tid; (void)lane; (void)gw
    unsigned char* ws = a.ws;
    float* mod = (float*)(ws + WS_MOD); float* rowss = (float*)(ws + WS_ROWSS); float* bias2 = (float*)(ws + WS_BIAS2); bf16* SH2 = (bf16*)(ws + WS_SH2);
    bf16 *Win_t = (bf16*)(ws + WS_WIN), *Wo_t = (bf16*)(ws + WS_WO), *W1_t = (bf16*)(ws + WS_W1), *W2_t = (bf16*)(ws + WS_W2);
    bf16 *XN = (bf16*)(ws + WS_XN), *HB = (bf16*)(ws + WS_HB), *BG = (bf16*)(ws + WS_BG), *CG = (bf16*)(ws + WS_CG), *UG = (bf16*)(ws + WS_UG), *QB = (bf16*)(ws + WS_QB);
    bf16 *KB = (bf16*)(ws + WS_KB), *VB = (bf16*)(ws + WS_VB), *MIX = (bf16*)(ws + WS_MIX);
    volatile LAS unsigned* MISC = (volatile LAS unsigned*)(lds + MISC_OFF);
    if (threadIdx.x < 32) MISC[threadIdx.x] = 0u;
    unsigned* barw = (unsigned*)(ws + WS_BAR);
    unsigned* qctr = (unsigned*)(ws + WS_QCTR); unsigned* maxbuf = (unsigned*)(ws + WS_MAXB);
    __syncthreads();
    const XcdBarrier bar = xcd_barrier_post(barw, MISC + 8);
#define GRID_SYNC() xcd_barrier(bar)
    if (a.never) grid.sync();

    { PHASE_IDS();
    if (bx < (6 * DM) / 64) {
        const int cb = bx * 64;
        LAS float* sl = (LAS float*)lds + wave * (64 * NMOD);
        float acc[NMOD];
#pragma unroll
        for (int r = 0; r < NMOD; ++r) acc[r] = 0.f;
        for (int half = 0; half < 2; ++half) {
            const int k0 = wave * 128 + half * 64;
            for (int idx = lane; idx < 64 * NMOD; idx += 64) { const int kk = idx & 63, r = idx >> 6;
                const float cv = r < NB_P ? a.c_p[r * DM + k0 + kk] : a.c_s[(r - NB_P) * DM + k0 + kk];
                sl[kk * NMOD + r] = cv / (1.f + __expf(-cv)); }
            LDS_WAIT(); asm volatile("" ::: "memory");
            for (int kk = 0; kk < 64; ++kk) {
                const float wv = a.w_ada[(size_t)(k0 + kk) * (6 * DM) + cb + lane];
                const LAS f32x4* sp = (const LAS f32x4*)(sl + kk * NMOD);
#pragma unroll
                for (int r4 = 0; r4 < NMOD / 4; ++r4) { const f32x4 sv = sp[r4]; acc[4 * r4] += sv.x * wv; acc[4 * r4 + 1] += sv.y * wv; acc[4 * r4 + 2] += sv.z * wv; acc[4 * r4 + 3] += sv.w * wv; }
            }
            LDS_WAIT(); asm volatile("" ::: "memory");
        }
        __syncthreads();
        LAS float* red = (LAS float*)lds;
#pragma unroll
        for (int r = 0; r < NMOD; ++r) red[(wave * NMOD + r) * 64 + lane] = acc[r];
        __syncthreads();
        for (int idx = tid; idx < NMOD * 64; idx += NTHREADS) { const int r = idx >> 6, cl = idx & 63; float s = a.b_ada[cb + cl];
#pragma unroll
            for (int w8 = 0; w8 < 8; ++w8) s += red[(w8 * NMOD + r) * 64 + cl];
            mod[(size_t)r * (6 * DM) + cb + cl] = s; }
        __syncthreads();
    }
    {
        LAS float* scr = (LAS float*)(lds + wave * 16384);
        constexpr int I_IN = (DM / 64) * (INW / 32), I_O = (DM / 64) * (DM / 32), I_1 = (DM / 64) * (FF / 32), I_2 = (FF / 64) * (DM / 32);
        constexpr int NITEMS = I_IN + I_O + I_1 + I_2;
        for (int it = gw; it < NITEMS; it += NGW) {
            int r = it;
            if (r < I_IN) { p0_transpose_item(a.w_in, DM, INW, Win_t, scr, r, lane); continue; } r -= I_IN;
            if (r < I_O) { p0_transpose_item(a.w_o, DM, DM, Wo_t, scr, r, lane); continue; } r -= I_O;
            if (r < I_1) { p0_transpose_item(a.w_mlp1, DM, FF, W1_t, scr, r, lane); continue; } r -= I_1;
            p0_transpose_item(a.w_mlp2, FF, DM, W2_t, scr, r, lane);
        }
        constexpr int NC = NB_S * PAST;
        for (int it0 = gw; it0 < 2 * NC; it0 += 4 * NGW) {
            f32x4 v0[4], v1[4];
#pragma unroll
            for (int q4 = 0; q4 < 4; ++q4) { const int it = (it0 + q4 * NGW < 2 * NC) ? it0 + q4 * NGW : it0; const int which = it >= NC, r = which ? it - NC : it;
                const float* src = (which ? a.cache_v : a.cache_k) + (size_t)r * HW + lane * 8; v0[q4] = *(const f32x4*)src; v1[q4] = *(const f32x4*)(src + 4); }
#pragma unroll
            for (int q4 = 0; q4 < 4; ++q4) { const int it = it0 + q4 * NGW; if (it < 2 * NC) { const int which = it >= NC, r = which ? it - NC : it, b = r >> 10, t = r & 1023;
                v4u o; o.x = pk2(v0[q4].x, v0[q4].y); o.y = pk2(v0[q4].z, v0[q4].w); o.z = pk2(v1[q4].x, v1[q4].y); o.w = pk2(v1[q4].z, v1[q4].w);
                *(v4u*)((which ? VB : KB) + (size_t)(MP + b * KVS + t) * HW + lane * 8) = o; } }
        }
        for (int it = gw; it < 2 * NB_S * 32; it += NGW) {
            const int which = it >= NB_S * 32, r = which ? it - NB_S * 32 : it, b = r >> 5, t = PAST + T_S + (r & 31);
            *(v4u*)((which ? VB : KB) + (size_t)(MP + b * KVS + t) * HW + lane * 8) = (v4u){0u, 0u, 0u, 0u};
        }
    }
    }
    GRID_SYNC();

    { PHASE_IDS();
    if (gw < 256) { unsigned long long* o8 = (unsigned long long*)(SH2 + (size_t)gw * DM) + lane; const f32x4* sp = (const f32x4*)(mod + (size_t)(gw < NMOD ? gw : 0) * (6 * DM) + 3 * DM) + lane;
#pragma unroll
        for (int j = 0; j < 4; ++j) { f32x4 r = sp[64 * j]; if (gw >= NMOD) r = (f32x4){0.f, 0.f, 0.f, 0.f}; o8[64 * j] = (unsigned long long)pk2(r.x, r.y) | ((unsigned long long)pk2(r.z, r.w) << 32); } }
    for (int m = gw; m < MT; m += 2 * NGW) {
        const int m2r = m + NGW; const bool h2 = m2r < MT; const int m2 = h2 ? m2r : m;
        const int mrow = m < MP ? (m >> 13) : NB_P + ((m - MP) >> 5), mrow2 = m2 < MP ? (m2 >> 13) : NB_P + ((m2 - MP) >> 5);
        const f32x4* xa = (const f32x4*)(m < MP ? a.x_p + (size_t)m * DM : a.x_s + (size_t)(m - MP) * DM) + lane;
        const f32x4* xb = (const f32x4*)(m2 < MP ? a.x_p + (size_t)m2 * DM : a.x_s + (size_t)(m2 - MP) * DM) + lane;
        const f32x4* ma = (const f32x4*)(mod + (size_t)mrow * (6 * DM)) + lane; const f32x4* mb = (const f32x4*)(mod + (size_t)mrow2 * (6 * DM)) + lane;
        f32x4 va[4], vb[4]; float sa = 0.f, sb = 0.f;
#pragma unroll
        for (int j = 0; j < 4; ++j) { va[j] = xa[64 * j]; vb[j] = xb[64 * j]; }
#pragma unroll
        for (int j = 0; j < 4; ++j) { sa += (va[j].x * va[j].x + va[j].y * va[j].y) + (va[j].z * va[j].z + va[j].w * va[j].w); sb += (vb[j].x * vb[j].x + vb[j].y * vb[j].y) + (vb[j].z * vb[j].z + vb[j].w * vb[j].w); }
        sa = wave_sum(sa); sb = wave_sum(sb);
        const float ra = 1.f / sqrtf(sa * (1.f / DM) + EPS), rb = 1.f / sqrtf(sb * (1.f / DM) + EPS);
        unsigned long long* oa = (unsigned long long*)(XN + (size_t)m * DM) + lane; unsigned long long* ob = (unsigned long long*)(XN + (size_t)m2 * DM) + lane;
#pragma unroll
        for (int j = 0; j < 4; ++j) { const f32x4 gg = ((const f32x4*)a.norm1_g)[lane + 64 * j];
            const f32x4 r1 = va[j] * ra * gg * (ma[DM / 4 + 64 * j] + 1.f) + ma[64 * j];
            oa[64 * j] = (unsigned long long)pk2(r1.x, r1.y) | ((unsigned long long)pk2(r1.z, r1.w) << 32);
            if (h2) { const f32x4 r2 = vb[j] * rb * gg * (mb[DM / 4 + 64 * j] + 1.f) + mb[64 * j];
                ob[64 * j] = (unsigned long long)pk2(r2.x, r2.y) | ((unsigned long long)pk2(r2.z, r2.w) << 32); } }
    } }
    GRID_SYNC();

    {
        pg8::Gemm g{XN, Win_t, MT, INW, DM}; pg8::StaticOrder S; S.init(MT, INW, G, bx, 1);
        pg8::EpiIn E{BG, CG, UG, QB, KB, VB, a.out, maxbuf};
        pg8::gemm_phase<pg8::EpiIn, pg8::StaticOrder, true, true>(lds, g, S, E);
    }
    GRID_SYNC();

    { PHASE_IDS();
        float lam;
        { float d1 = 0.f, d2 = 0.f; for (int i = 0; i < 64; ++i) { d1 += a.lq1[i] * a.lk1[i]; d2 += a.lq2[i] * a.lk2[i]; } lam = __expf(d1) - __expf(d2) + 0.2f; }
        constexpr int NQI = 256 + (NB_S * 4) / 8;
        int qi = (int)(bar.x & 7u);
        for (int nq = 0; nq < 8;) {
            if (tid == 0) MISC[0] = __hip_atomic_fetch_add(qctr + 64 * qi, 1u, __ATOMIC_RELAXED, __HIP_MEMORY_SCOPE_AGENT);
            __syncthreads();
            const int idx = (int)MISC[0];
            __syncthreads();
            if (idx >= NQI) { qi = (qi + 1) & 7; ++nq; continue; }
            att::UnitDesc d;
            if (idx < 256) {
                const int b = qi, h = 3 - (idx >> 6), qb = 63 - (idx & 63);
                const size_t row0 = (size_t)b * T_P + 128 * qb;
                d.Q = QB + row0 * HW + h * 128; d.K = KB + (size_t)b * T_P * HW + h * 128; d.V = VB + (size_t)b * T_P * HW + h * 128; d.O = MIX + row0 * DM + 512 + h * 128;
                d.q0pos = 128 * qb; d.nvalid = 128; d.kv_len = T_P; d.s_hi = qb; d.slope2 = LOG2E * exp2f(-2.f * (float)(h + 1));
                const unsigned* mq = maxbuf + b * 16 + h * 4; const unsigned* mk = mq + 128;
                const float B0 = sqrtf(__uint_as_float(mq[0]) * __uint_as_float(mk[0])) + sqrtf(__uint_as_float(mq[1]) * __uint_as_float(mk[1]));
                const float B1 = sqrtf(__uint_as_float(mq[2]) * __uint_as_float(mk[2])) + sqrtf(__uint_as_float(mq[3]) * __uint_as_float(mk[3]));
                const float Tn = 2.04f * fmaxf(B0, B1) + 160.f, X = ((float)d.q0pos - 127.f - Tn / d.slope2) * (1.f / 128.f);
                int slo = X > 0.f ? (int)floorf(X) : 0; d.s_lo = slo < qb ? slo : qb;
            } else {
                const int us = qi * ((NB_S * 4) / 8) + idx - 256, b = us >> 2, h = us & 3;
                const size_t row0 = (size_t)MP + b * T_S, kr0 = (size_t)MP + (size_t)b * KVS;
                d.Q = QB + row0 * HW + h * 128; d.K = KB + kr0 * HW + h * 128; d.V = VB + kr0 * HW + h * 128; d.O = MIX + row0 * DM + 512 + h * 128;
                d.q0pos = PAST; d.nvalid = T_S; d.kv_len = PAST + T_S; d.s_hi = (KVS / 64) / 2; d.s_lo = 0; d.slope2 = LOG2E * exp2f(-2.f * (float)(h + 1));
            }
            att::attn_unit(lds, d, lam, a.subln_g);
        }
        const int ch0 = lane * 8;
        float w0[8], w1[8], w2[8];
#pragma unroll
        for (int e = 0; e < 8; ++e) { w0[e] = a.conv_w[ch0 + e]; w1[e] = a.conv_w[HW + ch0 + e]; w2[e] = a.conv_w[2 * HW + ch0 + e]; }
        for (int rb = 4 * gw; rb < MT; rb += 4 * NGW) {
            const bool smp = rb >= MP; const int t0 = smp ? ((rb - MP) & 31) : (rb & (T_P - 1)), T = smp ? T_S : T_P, b = smp ? ((rb - MP) >> 5) : (rb >> 13);
            v4u cv[6], uv[6], bv[4];
#pragma unroll
            for (int k = 0; k < 6; ++k) { const int rk = (t0 - 2 + k >= 0) ? rb - 2 + k : rb;
                cv[k] = *(const v4u*)(CG + (size_t)rk * HW + ch0); uv[k] = *(const v4u*)(UG + (size_t)rk * HW + ch0); }
#pragma unroll
            for (int i2 = 0; i2 < 4; ++i2) bv[i2] = *(const v4u*)(BG + (size_t)(rb + i2) * HW + ch0);
            float uc[6][8];
#pragma unroll
            for (int k = 0; k < 6; ++k) {
                uc[k][0] = bflo(cv[k].x) * bflo(uv[k].x); uc[k][1] = bfhi(cv[k].x) * bfhi(uv[k].x); uc[k][2] = bflo(cv[k].y) * bflo(uv[k].y); uc[k][3] = bfhi(cv[k].y) * bfhi(uv[k].y);
                uc[k][4] = bflo(cv[k].z) * bflo(uv[k].z); uc[k][5] = bfhi(cv[k].z) * bfhi(uv[k].z); uc[k][6] = bflo(cv[k].w) * bflo(uv[k].w); uc[k][7] = bfhi(cv[k].w) * bfhi(uv[k].w); }
            if (t0 == 0) {
#pragma unroll
                for (int k = 0; k < 2; ++k) {
                    if (smp) { const float* sp = a.state_conv + ((size_t)b * 2 + k) * HW + ch0; const f32x4 s0 = *(const f32x4*)sp, s1 = *(const f32x4*)(sp + 4);
                        uc[k][0] = s0.x; uc[k][1] = s0.y; uc[k][2] = s0.z; uc[k][3] = s0.w; uc[k][4] = s1.x; uc[k][5] = s1.y; uc[k][6] = s1.z; uc[k][7] = s1.w; }
                    else {
#pragma unroll
                        for (int e = 0; e < 8; ++e) uc[k][e] = 0.f; } }
            }
#pragma unroll
            for (int i2 = 0; i2 < 4; ++i2) {
                const float bb[8] = {bflo(bv[i2].x), bfhi(bv[i2].x), bflo(bv[i2].y), bfhi(bv[i2].y), bflo(bv[i2].z), bfhi(bv[i2].z), bflo(bv[i2].w), bfhi(bv[i2].w)};
                float y[8];
#pragma unroll
                for (int e = 0; e < 8; ++e) y[e] = bb[e] * (w0[e] * uc[i2][e] + w1[e] * uc[i2 + 1][e] + w2[e] * uc[i2 + 2][e]);
                v4u o; o.x = pk2(y[0], y[1]); o.y = pk2(y[2], y[3]); o.z = pk2(y[4], y[5]); o.w = pk2(y[6], y[7]);
                *(v4u*)(MIX + (size_t)(rb + i2) * DM + ch0) = o;
                const int t = t0 + i2;
                if (t >= T - 2) { float* cp = a.out + (smp ? O_CS : O_CP) + ((size_t)b * 2 + (t - (T - 2))) * HW + ch0;
                    *(f32x4*)cp = (f32x4){uc[i2 + 2][0], uc[i2 + 2][1], uc[i2 + 2][2], uc[i2 + 2][3]}; *(f32x4*)(cp + 4) = (f32x4){uc[i2 + 2][4], uc[i2 + 2][5], uc[i2 + 2][6], uc[i2 + 2][7]}; }
            }
        }
    }
    GRID_SYNC();

    {
        pg8::Gemm g{MIX, Wo_t, MT, DM, DM}; pg8::StaticOrder S; S.init(MT, DM, G, bx);
        pg8::EpiResGate2 E{a.x_p, a.x_s, a.out, mod + 2 * DM, mod + 4 * DM, a.norm2_g, XN, rowss};
        pg8::gemm_phase<pg8::EpiResGate2, pg8::StaticOrder, true, true>(lds, g, S, E);
        const int c2 = G >= 48 ? bx - 16 : bx;
        if (c2 >= 0 && c2 < 16) { pg8::Gemm gb{SH2, W1_t, 256, FF, DM, 0}; pg8::SplitOrder Sb{1, FF / 256, 1, 1, 16, c2};
            pg8::EpiPartial Eb{bias2, 1, 256, FF};
            pg8::gemm_phase<pg8::EpiPartial, pg8::SplitOrder, true, true>(lds, gb, Sb, Eb); }
    }
    GRID_SYNC();

    {
        pg8::Gemm g{XN, W1_t, MT, FF, DM}; pg8::StaticOrder S; S.init(MT, FF, G, bx);
        pg8::EpiRelu2N E{HB, FF, rowss, bias2};
        pg8::gemm_phase<pg8::EpiRelu2N, pg8::StaticOrder, true, true>(lds, g, S, E);
    }
    GRID_SYNC();

    {
        pg8::Gemm g{HB, W2_t, MP, DM, FF}; pg8::StaticOrder S; S.init(MP, DM, G, bx);
        pg8::EpiResGate E{a.out, a.out + (size_t)MP * DM, a.out, mod + 5 * DM};
        pg8::gemm_phase<pg8::EpiResGate, pg8::StaticOrder, true, true>(lds, g, S, E);
        pg8::Gemm g2{HB + (size_t)MP * FF, W2_t, MS, DM, FF, 256}; pg8::SplitOrder S2{MS / 256, DM / 256, FF / 256, 256, G, bx};
        pg8::EpiPartial E2{(float*)(ws + WS_XN), 256, MS, DM};
        pg8::gemm_phase<pg8::EpiPartial, pg8::SplitOrder, true, true>(lds, g2, S2, E2);
    }
    GRID_SYNC();

    { PHASE_IDS();
    constexpr int RW = 2;
    for (int m = gw; m < MP; m += RW * NGW) {
        f32x4 v[RW][4]; float ss[RW];
#pragma unroll
        for (int r = 0; r < RW; ++r) { const int mr = (m + r * NGW < MP) ? m + r * NGW : m; const f32x4* xp = (const f32x4*)(a.out + (size_t)mr * DM) + lane;
#pragma unroll
            for (int j = 0; j < 4; ++j) v[r][j] = xp[64 * j]; }
#pragma unroll
        for (int r = 0; r < RW; ++r) { float s = 0.f;
#pragma unroll
            for (int j = 0; j < 4; ++j) s += (v[r][j].x * v[r][j].x + v[r][j].y * v[r][j].y) + (v[r][j].z * v[r][j].z + v[r][j].w * v[r][j].w);
            ss[r] = 1.f / sqrtf(wave_sum(s) * (1.f / DM) + EPS); }
#pragma unroll
        for (int r = 0; r < RW; ++r) if (m + r * NGW < MP) { f32x4* xp = (f32x4*)(a.out + (size_t)(m + r * NGW) * DM) + lane;
#pragma unroll
            for (int j = 0; j < 4; ++j) xp[64 * j] = v[r][j] * ss[r] * ((const f32x4*)a.final_g)[lane + 64 * j]; }
    }
    for (int m = MP + gw; m < MT; m += NGW) {
        f32x4* xr = (f32x4*)(a.out + (size_t)m * DM) + lane;
        f32x4 v[4]; float s = 0.f;
#pragma unroll
        for (int j = 0; j < 4; ++j) v[j] = xr[64 * j];
        const f32x4* pp = (const f32x4*)(ws + WS_XN) + (size_t)(m - MP) * (DM / 4) + lane; const f32x4* gp = (const f32x4*)(mod + (size_t)(NB_P + ((m - MP) >> 5)) * (6 * DM) + 5 * DM) + lane;
        f32x4 t[4];
#pragma unroll
        for (int j = 0; j < 4; ++j) t[j] = pp[64 * j];
        for (int s2 = 1; s2 < FF / 256; ++s2) { pp += (size_t)MS * (DM / 4);
#pragma unroll
            for (int j = 0; j < 4; ++j) t[j] += pp[64 * j]; }
#pragma unroll
        for (int j = 0; j < 4; ++j) { v[j] += gp[64 * j] * t[j]; s += (v[j].x * v[j].x + v[j].y * v[j].y) + (v[j].z * v[j].z + v[j].w * v[j].w); }
        const float rstd = 1.f / sqrtf(wave_sum(s) * (1.f / DM) + EPS);
#pragma unroll
        for (int j = 0; j < 4; ++j) xr[64 * j] = v[j] * rstd * ((const f32x4*)a.final_g)[lane + 64 * j];
    } }
}

extern "C" void kernel_launch(void* const* d_in, const int* in_sizes, int n_in, void* d_out, int out_size, void* d_ws, size_t ws_size, hipStream_t stream) {
    static int grid = 0;
    if (grid == 0) {
        if (n_in != 22 || in_sizes[0] != MP * DM || (size_t)out_size != O_END || ws_size < WS_END) {
            fprintf(stderr, "kernel_launch: unexpected shapes: n_in %d in0 %d out %d ws %zu (need %zu)\n", n_in, n_in > 0 ? in_sizes[0] : -1, out_size, ws_size, (size_t)WS_END); grid = -1; return; }
        int dev = 0, cus = 0, per_cu = 0;
        (void)hipGetDevice(&dev); (void)hipDeviceGetAttribute(&cus, hipDeviceAttributeMultiprocessorCount, dev);
        if (hipFuncSetAttribute((const void*)mega_fwd, hipFuncAttributeMaxDynamicSharedMemorySize, LDS_BYTES) != hipSuccess) { fprintf(stderr, "kernel_launch: hipFuncSetAttribute failed\n"); grid = -1; return; }
        if (hipOccupancyMaxActiveBlocksPerMultiprocessor(&per_cu, (const void*)mega_fwd, NTHREADS, LDS_BYTES) != hipSuccess || per_cu < 1) { fprintf(stderr, "kernel_launch: occupancy query says %d\n", per_cu); per_cu = 1; }
        (void)hipGetLastError();
        grid = cus * per_cu;
        fprintf(stderr, "kernel_launch: grid %d (cus %d x %d)\n", grid, cus, per_cu);
    }
    if (grid < 0) return;
    Args a{};
    const float** p = (const float**)&a;
    for (int i = 0; i < 22; ++i) p[i] = (const float*)d_in[i];
    a.out = (float*)d_out; a.ws = (unsigned char*)d_ws;
    if (hipMemsetAsync((char*)d_ws + WS_BAR, 0, CTL_BYTES, stream) != hipSuccess) { fprintf(stderr, "kernel_launch: hipMemsetAsync failed\n"); return; }
    void* args[] = {&a};
    hipError_t e = hipLaunchCooperativeKernel((const void*)mega_fwd, dim3(grid), dim3(NTHREADS), args, LDS_BYTES, stream);
    if (e != hipSuccess) fprintf(stderr, "kernel_launch: cooperative launch failed: %s (grid %d)\n", hipGetErrorString(e), grid);
}
```
